# Optimizing an MI355X kernel written in HIP

```python
import jax, jax.numpy as jnp
from jax import lax
import numpy as np

D_MODEL = 2048
BATCH = 4
SEQ = 2048
DEPTH = 2

N_A_LAYERS = DEPTH // 2
N_B_LAYERS = DEPTH - N_A_LAYERS
PLE_DIM = 256
D_FF = 4 * D_MODEL
HGRN_HEAD_DIM = 128
HGRN_HEADS = D_MODEL // HGRN_HEAD_DIM
HGRN_CHUNK = 16
FOX_HEAD_DIM = 128
FOX_HEADS = D_MODEL // FOX_HEAD_DIM
Q_BLOCK = 128
EPS = 1e-6

kernel_name = "yoco_hgrn2_fox_hybrid"


def rms_norm(x, gain):
    xf = x.astype(jnp.float32)
    y = xf * lax.rsqrt(jnp.mean(xf * xf, axis=-1, keepdims=True) + EPS)
    return (y * gain.astype(jnp.float32)).astype(x.dtype)


def hgrn2_mixer(u, w_in, lb, head_gain, w_out):
    bsz, seq, _ = u.shape
    nc = seq // HGRN_CHUNK
    q, f, i, g = jnp.split(u @ w_in, 4, axis=-1)

    def to_chunks(t):
        t = t.reshape(bsz, nc, HGRN_CHUNK, HGRN_HEADS, HGRN_HEAD_DIM)
        return t.transpose(0, 3, 1, 2, 4).astype(jnp.float32)

    lb_h = lb.astype(jnp.float32).reshape(HGRN_HEADS, 1, 1, HGRN_HEAD_DIM)
    fg = lb_h + (1.0 - lb_h) * jax.nn.sigmoid(to_chunks(f))
    k = 1.0 - fg
    b = jnp.cumsum(jnp.log(fg), axis=3)
    b_last = b[:, :, :, -1:, :]
    qc = jax.nn.silu(to_chunks(q)) * (HGRN_HEAD_DIM ** -0.5)
    v = to_chunks(i)

    q_in = qc * jnp.exp(b)
    k_in = k * jnp.exp(-b)
    k_end = k * jnp.exp(b_last - b)
    causal = jnp.tril(jnp.ones((HGRN_CHUNK, HGRN_CHUNK), dtype=bool))
    att = jnp.where(causal, jnp.einsum('bhncd,bhnsd->bhncs', q_in, k_in), 0.0)
    o_intra = jnp.einsum('bhncs,bhnse->bhnce', att, v)

    def step(state, inp):
        q_n, k_n, v_n, dec_n = inp
        o_n = jnp.einsum('bhcd,bhde->bhce', q_n, state)
        state = dec_n[..., None] * state + jnp.einsum('bhcd,bhce->bhde', k_n, v_n)
        return state, o_n

    xs = (jnp.moveaxis(q_in, 2, 0), jnp.moveaxis(k_end, 2, 0), jnp.moveaxis(v, 2, 0),
          jnp.moveaxis(jnp.exp(b_last[:, :, :, 0, :]), 2, 0))
    init = jnp.zeros((bsz, HGRN_HEADS, HGRN_HEAD_DIM, HGRN_HEAD_DIM), jnp.float32)
    _, o_inter = lax.scan(step, init, xs)
    o = o_intra + jnp.moveaxis(o_inter, 0, 2)

    o = o.transpose(0, 2, 3, 1, 4).reshape(bsz, seq, HGRN_HEADS, HGRN_HEAD_DIM)
    o = o * lax.rsqrt(jnp.mean(o * o, axis=-1, keepdims=True) + EPS) * head_gain.astype(jnp.float32)
    o = o.reshape(bsz, seq, D_MODEL) * jax.nn.silu(g.astype(jnp.float32))
    return o.astype(u.dtype) @ w_out


def shared_kv(stream, kv_norm, w_kvf, b_f):
    bsz, seq, _ = stream.shape
    hk = rms_norm(stream, kv_norm) @ w_kvf
    k = hk[..., :D_MODEL].reshape(bsz, seq, FOX_HEADS, FOX_HEAD_DIM)
    v = hk[..., D_MODEL:2 * D_MODEL].reshape(bsz, seq, FOX_HEADS, FOX_HEAD_DIM)
    f_logit = hk[..., 2 * D_MODEL:].astype(jnp.float32) + b_f.astype(jnp.float32)
    dcum = jnp.cumsum(jax.nn.log_sigmoid(f_logit), axis=1).transpose(0, 2, 1)
    return k, v, dcum


def fox_mixer(u, k, v, dcum, w_q, w_out):
    bsz, seq, _ = u.shape
    q = (u @ w_q).reshape(bsz, seq, FOX_HEADS, FOX_HEAD_DIM) * (FOX_HEAD_DIM ** -0.5)
    outs = []
    for blk in range(seq // Q_BLOCK):
        start, end = blk * Q_BLOCK, (blk + 1) * Q_BLOCK
        logits = jnp.einsum('bqhd,bkhd->bhqk', q[:, start:end], k[:, :end]).astype(jnp.float32)
        logits = logits + dcum[:, :, start:end, None] - dcum[:, :, None, :end]
        causal = jnp.arange(start, end)[:, None] >= jnp.arange(end)[None, :]
        probs = jax.nn.softmax(jnp.where(causal, logits, -jnp.inf), axis=-1)
        outs.append(jnp.einsum('bhqk,bkhd->bqhd', probs.astype(v.dtype), v[:, :end]))
    o = jnp.concatenate(outs, axis=1).reshape(bsz, seq, D_MODEL)
    return o @ w_out


def sq_relu_mlp(u, w_up, w_down):
    hid = jax.nn.relu(u @ w_up)
    return (hid * hid) @ w_down


def setup_inputs(seed: int = 0) -> dict:
    key = jax.random.key(seed)
    ks = jax.random.split(key, 20)
    f32 = jnp.float32

    def dense(k, shape, fan_in):
        return jax.random.normal(k, shape, f32) * (fan_in ** -0.5)

    def gain(k, shape):
        return 1.0 + 0.02 * jax.random.normal(k, shape, f32)

    return {
        "x": jax.random.normal(ks[0], (BATCH, SEQ, D_MODEL), f32),
        "p": jax.random.normal(ks[1], (DEPTH, BATCH, SEQ, PLE_DIM), f32),
        "mix_norm": gain(ks[2], (DEPTH, D_MODEL)),
        "mlp_norm": gain(ks[3], (DEPTH, D_MODEL)),
        "ple_norm": gain(ks[4], (DEPTH, D_MODEL)),
        "w_a_in": dense(ks[5], (N_A_LAYERS, D_MODEL, 4 * D_MODEL), D_MODEL),
        "a_lb_logits": 0.3 * jax.random.normal(ks[6], (N_A_LAYERS + 1, D_MODEL), f32),
        "a_head_gain": gain(ks[7], (N_A_LAYERS, HGRN_HEAD_DIM)),
        "w_a_out": dense(ks[8], (N_A_LAYERS, D_MODEL, D_MODEL), D_MODEL),
        "kv_norm": gain(ks[9], (D_MODEL,)),
        "w_kvf": dense(ks[10], (D_MODEL, 2 * D_MODEL + FOX_HEADS), D_MODEL),
        "b_f": 2.0 + 0.5 * jax.random.normal(ks[11], (FOX_HEADS,), f32),
        "w_b_q": dense(ks[12], (N_B_LAYERS, D_MODEL, D_MODEL), D_MODEL),
        "w_b_out": dense(ks[13], (N_B_LAYERS, D_MODEL, D_MODEL), D_MODEL),
        "w_mlp_up": dense(ks[14], (DEPTH, D_MODEL, D_FF), D_MODEL),
        "w_mlp_down": dense(ks[15], (DEPTH, D_FF, D_MODEL), D_FF),
        "w_ple_gate": dense(ks[16], (DEPTH, D_MODEL, D_MODEL), D_MODEL),
        "w_ple_up": dense(ks[17], (DEPTH, PLE_DIM, D_MODEL), PLE_DIM),
        "final_norm": gain(ks[18], (D_MODEL,)),
    }


def reference(x, p, mix_norm, mlp_norm, ple_norm, w_a_in, a_lb_logits, a_head_gain, w_a_out,
              kv_norm, w_kvf, b_f, w_b_q, w_b_out, w_mlp_up, w_mlp_down, w_ple_gate, w_ple_up,
              final_norm):
    lb_all = jnp.cumsum(jax.nn.softmax(a_lb_logits.astype(jnp.float32), axis=0), axis=0)
    h = x
    k_sh = v_sh = d_sh = None
    for layer in range(DEPTH):
        u = rms_norm(h, mix_norm[layer])
        if layer < N_A_LAYERS:
            h = h + hgrn2_mixer(u, w_a_in[layer], lb_all[layer], a_head_gain[layer], w_a_out[layer])
        else:
            j = layer - N_A_LAYERS
            h = h + fox_mixer(u, k_sh, v_sh, d_sh, w_b_q[j], w_b_out[j])
        h = h + sq_relu_mlp(rms_norm(h, mlp_norm[layer]), w_mlp_up[layer], w_mlp_down[layer])
        gate = jax.nn.sigmoid(rms_norm(h, ple_norm[layer]) @ w_ple_gate[layer])
        h = h + (p[layer].astype(h.dtype) @ w_ple_up[layer]) * gate
        if layer == N_A_LAYERS - 1:
            k_sh, v_sh, d_sh = shared_kv(h, kv_norm, w_kvf, b_f)
    return rms_norm(h, final_norm)
```

```cpp
#include <hip/hip_runtime.h>
#include <hip/hip_bf16.h>
#include <hip/hip_cooperative_groups.h>
#include <cstdio>
#include <cstdint>
namespace cg = cooperative_groups;
namespace pg8 {
#define PG8_LAS __attribute__((address_space(3)))
typedef unsigned short bf16_t;
typedef short bf16x8 __attribute__((ext_vector_type(8)));
typedef float f32x4 __attribute__((ext_vector_type(4)));
typedef unsigned u32x4 __attribute__((ext_vector_type(4)));
constexpr int BM = 256, BK = 64, HALF = 128, HTB = HALF * BK * 2  , STAGE_BYTES = 8 * HTB, NXCD = 8, WGM = 8;

__host__ __device__ __forceinline__ int lds_byte(int r, int c) { const int st = (r >> 4) * 2 + (c >> 5), rr = r & 15, cc = c & 31, ob = rr * 64 + cc * 2; return st * 1024 + (ob ^ (((ob >> 9) & 1) << 5)); }
__host__ __device__ __forceinline__ void stage_rc(int b, int& R, int& C) { const int st = b / 1024, sb = b % 1024, swz = sb ^ (((sb >> 9) & 1) << 5); R = (st >> 1) * 16 + swz / 64; C = (st & 1) * 32 + (swz % 64) / 2; }
__host__ __device__ __forceinline__ int perm32(int rho) { const int n = rho >> 4, i = rho & 15; return 8 * (i >> 2) + 4 * n + (i & 3); }

struct Unit { int pm, pn; };
struct Gemm { const bf16_t* A; const bf16_t* Bt; int M, N, K; };

struct StaticOrder {
    int nM, nN, nwg, G, c;
    __host__ __device__ void init(int M, int N, int G_, int c_) { nM = M / BM; nN = N / BM; nwg = nM * nN; G = G_; c = c_; }
    __host__ __device__ bool next(int i, Unit& u) const {
        const long L = (long)i * G + c; if (L >= nwg) return false;
        int wgid = (int)L; { const int q = nwg / NXCD, r = nwg % NXCD, xcd = wgid % NXCD, off = wgid / NXCD; wgid = (xcd < r ? xcd * (q + 1) : r * (q + 1) + (xcd - r) * q) + off; }
        const int nig = WGM * nN, gid = wgid / nig, fm = gid * WGM, gsz = (nM - fm) < WGM ? (nM - fm) : WGM;
        u.pm = fm + ((wgid % nig) % gsz); u.pn = (wgid % nig) / gsz; return true;
    }
    __device__ __forceinline__ void a_ready(const Unit&) const {}
    __device__ __forceinline__ void done(const Unit&) const {}
};

__device__ __forceinline__ unsigned cvt_pk_bf16(float lo, float hi) { unsigned r; asm volatile("v_cvt_pk_bf16_f32 %0, %1, %2" : "=v"(r) : "v"(lo), "v"(hi)); return r; }
typedef float f32x2 __attribute__((ext_vector_type(2)));
typedef unsigned u32x2 __attribute__((ext_vector_type(2)));
__device__ __forceinline__ float sigmoidf_(float x) { return __builtin_amdgcn_rcpf(1.0f + __expf(-x)); }
__device__ __forceinline__ u32x2 pack4(f32x4 v) { u32x2 w; w.x = cvt_pk_bf16(v[0], v[1]); w.y = cvt_pk_bf16(v[2], v[3]); return w; }
__device__ __forceinline__ float bf_lo(unsigned w) { return __uint_as_float(w << 16); }
__device__ __forceinline__ float bf_hi(unsigned w) { return __uint_as_float(w & 0xffff0000u); }
constexpr float RMS_EPS = 1e-6f;
typedef long long ss_t;
constexpr float SS_SCALE = 1048576.0f;
__device__ __forceinline__ float ss_rs(const ss_t* ss, int row) { return rsqrtf((float)ss[row] * (1.0f / (1048576.0f * 2048.0f)) + RMS_EPS); }
__device__ __forceinline__ void ss_add(ss_t* ss, int row, float s) { __hip_atomic_fetch_add(ss + row, (ss_t)(s * SS_SCALE), __ATOMIC_RELAXED, __HIP_MEMORY_SCOPE_AGENT); }
constexpr int LDM = 2048;

typedef unsigned u32x4e __attribute__((ext_vector_type(4)));
__device__ __forceinline__ u32x4e pack8(f32x4 a, f32x4 b) { u32x4e w; w.x = cvt_pk_bf16(a[0], a[1]); w.y = cvt_pk_bf16(a[2], a[3]); w.z = cvt_pk_bf16(b[0], b[1]); w.w = cvt_pk_bf16(b[2], b[3]); return w; }
__device__ __forceinline__ void unpack8(u32x4e w, f32x4& a, f32x4& b) { a = (f32x4){bf_lo(w.x), bf_hi(w.x), bf_lo(w.y), bf_hi(w.y)}; b = (f32x4){bf_lo(w.z), bf_hi(w.z), bf_lo(w.w), bf_hi(w.w)}; }
template <int CTRL> __device__ __forceinline__ float dpp_shr0(float x) { return __builtin_bit_cast(float, __builtin_amdgcn_update_dpp(0, __builtin_bit_cast(int, x), CTRL, 0xf, 0xf, false)); }
struct EpiG1 {
    static constexpr bool PERM = true, AFTER_DRAIN = false;
    const float* rs; const float* lb; bf16_t* QIN; bf16_t* KIN; float* DEC; bf16_t* V0; bf16_t* SG;
    __device__ __forceinline__ void operator()(const f32x4 (&acc)[2][2][4][2], const Unit& u, int wr, int wc, int fr, int fq) const {
        const int type = ((u.pn >> 2) ^ u.pn) & 1; const int col = (u.pn >> 1) * 128 + wc * 32 + fq * 8;
#pragma unroll
        for (int ai = 0; ai < 2; ++ai)
#pragma unroll
            for (int m = 0; m < 4; ++m) { const int row = u.pm * BM + ai * HALF + wr * 64 + m * 16 + fr; const float r = rs[row]; const size_t off = (size_t)row * LDM + col;
                if (type == 1) { f32x4 o[2];
#pragma unroll
                    for (int n = 0; n < 2; ++n)
#pragma unroll
                        for (int i = 0; i < 4; ++i) { const float g = acc[ai][1][m][n][i] * r; o[n][i] = g * sigmoidf_(g); }
                    *(u32x4e*)(V0 + off) = pack8(acc[ai][0][m][0] * r, acc[ai][0][m][1] * r); *(u32x4e*)(SG + off) = pack8(o[0], o[1]); }
                else { f32x4 qi[2], ki[2], de[2];
#pragma unroll
                    for (int n = 0; n < 2; ++n) { const f32x4 l = *(const f32x4*)(lb + col + 4 * n);
#pragma unroll
                        for (int i = 0; i < 4; ++i) { const float qv = acc[ai][0][m][n][i] * r, fv = acc[ai][1][m][n][i] * r;
                            const float fg = l[i] + (1.0f - l[i]) * sigmoidf_(fv); float b = __logf(fg);
                            b += dpp_shr0<0x111>(b); b += dpp_shr0<0x112>(b); b += dpp_shr0<0x114>(b); b += dpp_shr0<0x118>(b);
                            const float bl = __shfl(b, 15, 16); const float eb = __expf(b), kk = 1.0f - fg, ebi = __builtin_amdgcn_rcpf(eb), dl = __expf(bl);
                            qi[n][i] = qv * sigmoidf_(qv) * 0.08838834764831845f * eb; ki[n][i] = kk * ebi; de[n][i] = dl; } }
                    *(u32x4e*)(QIN + off) = pack8(qi[0], qi[1]); *(u32x4e*)(KIN + off) = pack8(ki[0], ki[1]);
                    if (fr == 15) { float* d = DEC + (size_t)(row >> 4) * LDM + col; *(f32x4*)d = de[0]; *(f32x4*)(d + 4) = de[1]; } } }
    }
};
struct EpiStore {
    static constexpr bool PERM = true, AFTER_DRAIN = false;
    bf16_t* dst; size_t rstride; const ss_t* ss;
    __device__ __forceinline__ void operator()(const f32x4 (&acc)[2][2][4][2], const Unit& u, int wr, int wc, int fr, int fq) const {
        bf16_t* d = dst + (size_t)(u.pn >> 3) * rstride; const int cb = (u.pn & 7) * 256 + wc * 32 + fq * 8;
#pragma unroll
        for (int ai = 0; ai < 2; ++ai)
#pragma unroll
            for (int m = 0; m < 4; ++m) { const int row = u.pm * BM + ai * HALF + wr * 64 + m * 16 + fr; const float r = ss ? ss_rs(ss, row) : 1.0f;
#pragma unroll
                for (int bj = 0; bj < 2; ++bj) { const size_t off = (size_t)row * LDM + cb + bj * HALF; *(u32x4e*)(d + off) = pack8(acc[ai][bj][m][0] * r, acc[ai][bj][m][1] * r); } }
    }
};
struct EpiUp {
    static constexpr bool PERM = true, AFTER_DRAIN = false;
    bf16_t* dst; const ss_t* ss;
    __device__ __forceinline__ void operator()(const f32x4 (&acc)[2][2][4][2], const Unit& u, int wr, int wc, int fr, int fq) const {
        const int cb = u.pn * 256 + wc * 32 + fq * 8;
#pragma unroll
        for (int ai = 0; ai < 2; ++ai)
#pragma unroll
            for (int m = 0; m < 4; ++m) { const int row = u.pm * BM + ai * HALF + wr * 64 + m * 16 + fr; const float r = ss_rs(ss, row);
#pragma unroll
                for (int bj = 0; bj < 2; ++bj) { const size_t off = (size_t)row * 8192 + cb + bj * HALF; f32x4 v[2];
#pragma unroll
                    for (int n = 0; n < 2; ++n)
#pragma unroll
                        for (int i = 0; i < 4; ++i) { const float t = fmaxf(acc[ai][bj][m][n][i] * r, 0.f); v[n][i] = t * t; }
                    *(u32x4e*)(dst + off) = pack8(v[0], v[1]); } }
    }
};
template <bool BASE_F32> struct EpiRes {
    static constexpr bool PERM = true, AFTER_DRAIN = false;
    const void* base; bf16_t* outb; ss_t* ssout;
    __device__ __forceinline__ void operator()(const f32x4 (&acc)[2][2][4][2], const Unit& u, int wr, int wc, int fr, int fq) const {
        const int cb = u.pn * 256 + wc * 32 + fq * 8;
#pragma unroll
        for (int ai = 0; ai < 2; ++ai)
#pragma unroll
            for (int m = 0; m < 4; ++m) { const int row = u.pm * BM + ai * HALF + wr * 64 + m * 16 + fr; float s = 0.f;
#pragma unroll
                for (int bj = 0; bj < 2; ++bj) { const size_t off = (size_t)row * LDM + cb + bj * HALF; f32x4 h0, h1;
                    if (BASE_F32) { h0 = __builtin_nontemporal_load((const f32x4*)((const float*)base + off)); h1 = __builtin_nontemporal_load((const f32x4*)((const float*)base + off + 4)); }
                    else unpack8(__builtin_nontemporal_load((const u32x4e*)((const bf16_t*)base + off)), h0, h1);
                    h0 = h0 + acc[ai][bj][m][0]; h1 = h1 + acc[ai][bj][m][1];
                    *(u32x4e*)(outb + off) = pack8(h0, h1);
                    s += ((h0[0] * h0[0] + h0[1] * h0[1]) + (h0[2] * h0[2] + h0[3] * h0[3])) + ((h1[0] * h1[0] + h1[1] * h1[1]) + (h1[2] * h1[2] + h1[3] * h1[3])); }
                s += __shfl_xor(s, 16); s += __shfl_xor(s, 32);
                if (fq == 0) ss_add(ssout, row, s); }
    }
};
template <bool OUT_F32> struct EpiGate {
    static constexpr bool PERM = true, AFTER_DRAIN = false;
    const bf16_t* base; float* outf; bf16_t* outb; ss_t* ssout; const ss_t* ss; const bf16_t* pu;
    __device__ __forceinline__ void operator()(const f32x4 (&acc)[2][2][4][2], const Unit& u, int wr, int wc, int fr, int fq) const {
        const int cb = u.pn * 256 + wc * 32 + fq * 8;
#pragma unroll
        for (int ai = 0; ai < 2; ++ai)
#pragma unroll
            for (int m = 0; m < 4; ++m) { const int row = u.pm * BM + ai * HALF + wr * 64 + m * 16 + fr; float s = 0.f; const float r = ss_rs(ss, row);
#pragma unroll
                for (int bj = 0; bj < 2; ++bj) { const size_t off = (size_t)row * LDM + cb + bj * HALF; f32x4 h[2], p[2];
                    unpack8(__builtin_nontemporal_load((const u32x4e*)(base + off)), h[0], h[1]); unpack8(__builtin_nontemporal_load((const u32x4e*)(pu + off)), p[0], p[1]);
#pragma unroll
                    for (int n = 0; n < 2; ++n)
#pragma unroll
                        for (int i = 0; i < 4; ++i) { h[n][i] += p[n][i] * sigmoidf_(acc[ai][bj][m][n][i] * r); s += h[n][i] * h[n][i]; }
                    if (OUT_F32) { *(f32x4*)(outf + off) = h[0]; *(f32x4*)(outf + off + 4) = h[1]; } else *(u32x4e*)(outb + off) = pack8(h[0], h[1]); }
                s += __shfl_xor(s, 16); s += __shfl_xor(s, 32);
                if (fq == 0) ss_add(ssout, row, s); }
    }
};
template <class Epi, class Sched, bool ALIGN_EPI = false, bool SP2 = false>
__device__ __forceinline__ void gemm_phase(PG8_LAS unsigned char* lds, const Gemm g, const Sched& S, const Epi& E) {
    const int tid = threadIdx.x, wid = __builtin_amdgcn_readfirstlane(tid >> 6), lane = tid & 63, wr = wid >> 2, wc = wid & 3, fr = lane & 15, fq = lane >> 4;
    const int K = g.K, nt = K / BK;
    unsigned voffA[2], voffB[2];
#pragma unroll
    for (int i = 0; i < 2; ++i) { int R, C; stage_rc(tid * 16 + i * 8192, R, C); const int Rb = Epi::PERM ? ((R & ~31) + perm32(R & 31)) : R;
        voffA[i] = (unsigned)(R * K + C) * 2u; voffB[i] = (unsigned)(Rb * K + C) * 2u; }
    const size_t kstep = (size_t)(BK * 2);
    const size_t hstep = (size_t)HALF * K * 2;
    const size_t tstep = 2 * hstep;
    const unsigned ldsw = (unsigned)wid * 1024u;
    const int aoff = lds_byte(wr * 64 + fr, fq * 8), boff = lds_byte(wc * 32 + fr, fq * 8);
#define PG8_SA(b, h) (((b) * 2 + (h)) * HTB)
#define PG8_SB(b, h) ((4 + (b) * 2 + (h)) * HTB)
#define PG8_STAGE(bufoff, gbase, voff) do { _Pragma("unroll") for (int _i = 0; _i < 2; ++_i) \
        __builtin_amdgcn_global_load_lds((const unsigned*)((const char*)(gbase) + (voff)[_i]), (PG8_LAS unsigned*)(lds + (bufoff) + ldsw + _i * 8192), 16, 0, 0); } while (0)
#define PG8_LDA(dst, b, h) do { _Pragma("unroll") for (int m = 0; m < 4; ++m) _Pragma("unroll") for (int k = 0; k < 2; ++k) dst[m][k] = *(const PG8_LAS bf16x8*)(lds + PG8_SA(b, h) + aoff + m * 2048 + k * 1024); } while (0)
#define PG8_LDB(dst, b, h) do { _Pragma("unroll") for (int n = 0; n < 2; ++n) _Pragma("unroll") for (int k = 0; k < 2; ++k) dst[n][k] = *(const PG8_LAS bf16x8*)(lds + PG8_SB(b, h) + boff + n * 2048 + k * 1024); } while (0)
#define PG8_MMA(ai, bj, At, Bt) do { __builtin_amdgcn_s_setprio(1); _Pragma("unroll") for (int m = 0; m < 4; ++m) _Pragma("unroll") for (int n = 0; n < 2; ++n) _Pragma("unroll") for (int k = 0; k < 2; ++k) \
        acc[ai][bj][m][n] = __builtin_amdgcn_mfma_f32_16x16x32_bf16(Bt[n][k], At[m][k], acc[ai][bj][m][n], 0, 0, 0); __builtin_amdgcn_s_setprio(0); } while (0)
#define PG8_WAIT_V(n) asm volatile("s_waitcnt vmcnt(" #n ")" ::: "memory")
#define PG8_WAIT_L(n) asm volatile("s_waitcnt lgkmcnt(" #n ")" ::: "memory")
#define PG8_BAR __builtin_amdgcn_s_barrier()
#define PG8_SCHED __builtin_amdgcn_sched_barrier(0)
    Unit cur, nxt; int ui = 0;
    if (!S.next(0, cur)) return;
    f32x4 acc[2][2][4][2];
#pragma unroll
    for (int a = 0; a < 2; ++a)
#pragma unroll
        for (int b = 0; b < 2; ++b)
#pragma unroll
            for (int m = 0; m < 4; ++m)
#pragma unroll
                for (int n = 0; n < 2; ++n) acc[a][b][m][n] = (f32x4){0.f, 0.f, 0.f, 0.f};
    bf16x8 At[4][2], B0[2][2], B1[2][2];
    const char* cA = (const char*)g.A + (size_t)cur.pm * tstep; const char* cB = (const char*)g.Bt + (size_t)cur.pn * tstep;
    S.a_ready(cur);
    if constexpr (SP2) {
        PG8_STAGE(PG8_SB(0, 0), cB, voffB); PG8_STAGE(PG8_SB(0, 1), cB + hstep, voffB); PG8_STAGE(PG8_SA(0, 0), cA, voffA); PG8_STAGE(PG8_SA(0, 1), cA + hstep, voffA);
        if (wr == 1) PG8_BAR;
        PG8_WAIT_V(2); PG8_BAR;
        PG8_STAGE(PG8_SB(1, 0), cB + kstep, voffB); PG8_STAGE(PG8_SA(1, 0), cA + kstep, voffA); PG8_STAGE(PG8_SB(1, 1), cB + hstep + kstep, voffB);
        PG8_WAIT_V(6); PG8_BAR;
    } else {
        PG8_STAGE(PG8_SB(0, 0), cB, voffB); PG8_STAGE(PG8_SA(0, 0), cA, voffA); PG8_STAGE(PG8_SB(0, 1), cB + hstep, voffB); PG8_STAGE(PG8_SA(0, 1), cA + hstep, voffA);
        if (wr == 1) PG8_BAR;
        PG8_WAIT_V(4); PG8_BAR;
        PG8_STAGE(PG8_SB(1, 0), cB + kstep, voffB); PG8_STAGE(PG8_SA(1, 0), cA + kstep, voffA); PG8_STAGE(PG8_SB(1, 1), cB + hstep + kstep, voffB);
        PG8_WAIT_V(6); PG8_BAR;
    }
    for (;;) {
        const bool has_next = S.next(ui + 1, nxt);
        const char* nA = has_next ? (const char*)g.A + (size_t)nxt.pm * tstep : cA; const char* nB = has_next ? (const char*)g.Bt + (size_t)nxt.pn * tstep : cB;
        for (int t = 0; t < nt; t += 2) {
            const bool last = (t == nt - 2);
            const char* a1 = cA + (size_t)(t + 1) * kstep;
            const char* a2 = last ? nA : cA + (size_t)(t + 2) * kstep; const char* b2 = last ? nB : cB + (size_t)(t + 2) * kstep;
            const char* a3 = a2 + kstep; const char* b3 = b2 + kstep;
            if (last && has_next) S.a_ready(nxt);
            if constexpr (SP2) {
            PG8_LDB(B0, 0, 0); PG8_LDB(B1, 0, 1); PG8_SCHED; PG8_LDA(At, 0, 0); PG8_STAGE(PG8_SA(1, 1), a1 + hstep, voffA);
            PG8_WAIT_V(8); PG8_WAIT_L(0); PG8_BAR; PG8_MMA(0, 0, At, B0); PG8_MMA(0, 1, At, B1); PG8_BAR; PG8_SCHED;
            PG8_LDA(At, 0, 1); PG8_STAGE(PG8_SB(0, 0), b2, voffB); PG8_STAGE(PG8_SB(0, 1), b2 + hstep, voffB); PG8_STAGE(PG8_SA(0, 0), a2, voffA);
            PG8_WAIT_V(8); PG8_WAIT_L(0); PG8_BAR; PG8_MMA(1, 0, At, B0); PG8_MMA(1, 1, At, B1); PG8_BAR; PG8_SCHED;
            PG8_LDB(B0, 1, 0); PG8_LDB(B1, 1, 1); PG8_SCHED; PG8_LDA(At, 1, 0); PG8_STAGE(PG8_SA(0, 1), a2 + hstep, voffA);
            PG8_WAIT_V(8); PG8_WAIT_L(0); PG8_BAR; PG8_MMA(0, 0, At, B0); PG8_MMA(0, 1, At, B1); PG8_BAR; PG8_SCHED;
            PG8_LDA(At, 1, 1); PG8_STAGE(PG8_SB(1, 0), b3, voffB); PG8_STAGE(PG8_SB(1, 1), b3 + hstep, voffB); PG8_STAGE(PG8_SA(1, 0), a3, voffA);
            PG8_WAIT_V(8); PG8_WAIT_L(0); PG8_BAR; PG8_MMA(1, 0, At, B0); PG8_MMA(1, 1, At, B1); PG8_BAR; PG8_SCHED;
            } else {
            PG8_LDB(B0, 0, 0); PG8_SCHED; PG8_LDA(At, 0, 0); PG8_STAGE(PG8_SA(1, 1), a1 + hstep, voffA);
            PG8_WAIT_L(8); PG8_BAR; PG8_WAIT_L(0); PG8_MMA(0, 0, At, B0); PG8_BAR; PG8_SCHED;
            PG8_LDB(B1, 0, 1); PG8_STAGE(PG8_SB(0, 0), b2, voffB);
            PG8_BAR; PG8_WAIT_L(0); PG8_MMA(0, 1, At, B1); PG8_BAR;
            PG8_LDA(At, 0, 1); PG8_STAGE(PG8_SA(0, 0), a2, voffA);
            PG8_BAR; PG8_WAIT_L(0); PG8_MMA(1, 0, At, B0); PG8_BAR; PG8_SCHED;
            PG8_STAGE(PG8_SB(0, 1), b2 + hstep, voffB);
            PG8_WAIT_V(6); PG8_BAR; PG8_MMA(1, 1, At, B1); PG8_BAR;
            PG8_LDB(B0, 1, 0); PG8_SCHED; PG8_LDA(At, 1, 0); PG8_STAGE(PG8_SA(0, 1), a2 + hstep, voffA);
            PG8_WAIT_L(8); PG8_BAR; PG8_WAIT_L(0); PG8_MMA(0, 0, At, B0); PG8_BAR; PG8_SCHED;
            PG8_LDB(B1, 1, 1); PG8_STAGE(PG8_SB(1, 0), b3, voffB);
            PG8_BAR; PG8_WAIT_L(0); PG8_MMA(0, 1, At, B1); PG8_BAR;
            PG8_LDA(At, 1, 1); PG8_STAGE(PG8_SA(1, 0), a3, voffA);
            PG8_BAR; PG8_WAIT_L(0); PG8_MMA(1, 0, At, B0); PG8_BAR; PG8_SCHED;
            PG8_STAGE(PG8_SB(1, 1), b3 + hstep, voffB);
            PG8_WAIT_V(6); PG8_BAR; PG8_MMA(1, 1, At, B1); PG8_BAR;
            }
        }
        if constexpr (ALIGN_EPI) { if (wr == 0) PG8_BAR; }
        if constexpr (!Epi::AFTER_DRAIN) { E(acc, cur, wr, wc, fr, fq); S.done(cur); }
        if (!has_next) break;
#pragma unroll
        for (int a = 0; a < 2; ++a)
#pragma unroll
            for (int b = 0; b < 2; ++b)
#pragma unroll
                for (int m = 0; m < 4; ++m)
#pragma unroll
                    for (int n = 0; n < 2; ++n) acc[a][b][m][n] = (f32x4){0.f, 0.f, 0.f, 0.f};
        cur = nxt; cA = nA; cB = nB; ++ui;
        if constexpr (ALIGN_EPI) { if (wr == 1) PG8_BAR; }
    }
    PG8_WAIT_V(0);
    if constexpr (!ALIGN_EPI) { if (wr == 0) PG8_BAR; }
    PG8_BAR;
    if constexpr (Epi::AFTER_DRAIN) { E.fused(acc, cur, wr, wc, fr, fq, lds, wid, lane); S.done(cur); }
#undef PG8_SA
#undef PG8_SB
#undef PG8_STAGE
#undef PG8_LDA
#undef PG8_LDB
#undef PG8_MMA
#undef PG8_WAIT_V
#undef PG8_WAIT_L
#undef PG8_BAR
#undef PG8_SCHED
}
}
namespace attn {
constexpr int D = 128, LDR = 2048, QLDS_OFF = 78080; constexpr float THR = 32.f;   constexpr bool WSKIP = false;
constexpr float SCALE = 0.08838834764831845f;
constexpr int NW = 8, QBLK = 32, KVBLK = 64, QB = NW * QBLK;
constexpr int SHM_V = KVBLK * D * 2, SHM_K = KVBLK * D * 2;
constexpr int LDS_BYTES = 2 * SHM_V + 2 * SHM_K + NW * 64 * 4;


using bf16 = __hip_bfloat16;
typedef short bf16x8 __attribute__((ext_vector_type(8)));
typedef short s16x4 __attribute__((ext_vector_type(4)));
typedef float f32x16 __attribute__((ext_vector_type(16)));
typedef float f32x4 __attribute__((ext_vector_type(4)));
typedef unsigned u32x4 __attribute__((ext_vector_type(4)));
template <class A, class Bt> struct same_t { static constexpr bool v = false; };
template <class A> struct same_t<A, A> { static constexpr bool v = true; };

#define KSWZ(row, colB) ((row) * 256 + ((colB) ^ (((row) & 7) << 4)))
#define SBAR() __builtin_amdgcn_sched_barrier(0)
__device__ __forceinline__ int v_st(int k, int c) { const int kk = (k & ~0xC) | ((k & 4) << 1) | ((k & 8) >> 1); return ((kk >> 3) * 4 + (c >> 5)) * 512 + ((kk & 7) * 32 + (c & 31)) * 2; }
__device__ __forceinline__ int v_rd_base(int lane) { return ((lane & 3) << 3) | (((lane >> 2) & 3) << 6) | (((lane >> 4) & 1) << 5) | (((lane >> 5) & 1) << 8); }
constexpr int v_rd_off(int d0, int ks, int half) { return d0 * 512 + ks * 4096 + half * 2048; }
__device__ __forceinline__ int crow(int r, int hi) { return (r & 3) + 8 * (r >> 2) + 4 * hi; }
__device__ __forceinline__ unsigned cvtpk(float lo, float hi) {
    unsigned r; asm volatile("v_cvt_pk_bf16_f32 %0, %1, %2" : "=v"(r) : "v"(lo), "v"(hi)); return r;
}
__device__ __forceinline__ bf16x8 pack8(f32x4 a, f32x4 b) {
    u32x4 w = {cvtpk(a[0], a[1]), cvtpk(a[2], a[3]), cvtpk(b[0], b[1]), cvtpk(b[2], b[3])};
    return *reinterpret_cast<bf16x8*>(&w);
}
template <class T> __device__ __forceinline__ bf16x8 load8(const T* p) {
    if constexpr (same_t<T, float>::v) { return pack8(*(const f32x4*)p, *(const f32x4*)(p + 4)); }
    else { return *reinterpret_cast<const bf16x8*>(p); }
}
__device__ __forceinline__ void mask_tile(f32x16& p0, f32x16& p1, int dq, unsigned W) {
    const float NEG = -__builtin_inff();
#pragma unroll
    for (int r = 0; r < 16; ++r) {
        const int c = (r & 3) + 8 * (r >> 2);
        if ((unsigned)(dq - c) >= W) p0[r] = NEG;
        if ((unsigned)(dq - c - 32) >= W) p1[r] = NEG;
    }
}
__device__ __forceinline__ void partialSM(f32x16& p0, f32x16& p1, float& m_reg, float& mn, float& alpha, float mfloor) {
    float pmax = p0[0]; for (int r = 1; r < 16; ++r) pmax = fmaxf(pmax, p0[r]); for (int r = 0; r < 16; ++r) pmax = fmaxf(pmax, p1[r]);
    { auto rr = __builtin_amdgcn_permlane32_swap(__float_as_uint(pmax), __float_as_uint(pmax), false, false);
      pmax = fmaxf(__uint_as_float(rr[0]), __uint_as_float(rr[1])); }
    constexpr float C2 = 1.4426950408889634f * SCALE;
    if (__builtin_expect(__all((pmax - m_reg) * SCALE <= THR), 1)) { mn = m_reg; alpha = 1.f; }
    else { mn = fmaxf(fmaxf(m_reg, pmax), mfloor); alpha = __builtin_amdgcn_exp2f((m_reg - mn) * C2); m_reg = mn; }
    const float mnL = -mn * C2;
    for (int r = 0; r < 16; ++r) p0[r] = fmaf(p0[r], C2, mnL); for (int r = 0; r < 16; ++r) p1[r] = fmaf(p1[r], C2, mnL);
    for (int r = 0; r < 16; ++r) p0[r] = __builtin_amdgcn_exp2f(p0[r]);
}
__device__ __forceinline__ void finishSM(f32x16& p0, f32x16& p1, float alpha, float& l_reg, bf16x8& pa0, bf16x8& pa1, bf16x8& pa2, bf16x8& pa3) {
    for (int r = 0; r < 16; ++r) p1[r] = __builtin_amdgcn_exp2f(p1[r]);
    float ps = 0; for (int r = 0; r < 16; ++r) ps += p0[r]; for (int r = 0; r < 16; ++r) ps += p1[r];
    { auto rr = __builtin_amdgcn_permlane32_swap(__float_as_uint(ps), __float_as_uint(ps), false, false);
      ps = __uint_as_float(rr[0]) + __uint_as_float(rr[1]); }
    l_reg = l_reg * alpha + ps;
#define PK4(P, B_, OUT) do { unsigned a0 = cvtpk(P[B_+0], P[B_+1]), a1 = cvtpk(P[B_+2], P[B_+3]);                          \
        unsigned b0 = cvtpk(P[B_+4], P[B_+5]), b1 = cvtpk(P[B_+6], P[B_+7]);                                             \
        auto r0 = __builtin_amdgcn_permlane32_swap(a0, b0, false, false); auto r1 = __builtin_amdgcn_permlane32_swap(a1, b1, false, false); \
        u32x4 w = {r0[0], r1[0], r0[1], r1[1]}; OUT = *reinterpret_cast<bf16x8*>(&w); } while (0)
    PK4(p0, 0, pa0); PK4(p0, 8, pa1); PK4(p1, 0, pa2); PK4(p1, 8, pa3);
#undef PK4
}
template <int KB, bool SK>
__device__ __forceinline__ void qkt(f32x16& p0, f32x16& p1, const char* K_lds, int r32, int hi, const char* qlds, bool act, const float* nbp) {
    if (SK && !act) { const float NEG = -__builtin_inff();
#pragma unroll
        for (int r = 0; r < 16; ++r) { p0[r] = NEG; p1[r] = NEG; } return; }
    { _Pragma("unroll") for (int j_ = 0; j_ < 4; ++j_) { const f32x4 b0_ = *(const f32x4*)(nbp + 8 * j_), b1_ = *(const f32x4*)(nbp + 32 + 8 * j_);
        _Pragma("unroll") for (int i_ = 0; i_ < 4; ++i_) { p0[4 * j_ + i_] = b0_[i_]; p1[4 * j_ + i_] = b1_[i_]; } } }
    const char* kb[4];
#pragma unroll
    for (int dd = 0; dd < 4; ++dd) kb[dd] = K_lds + KB * SHM_K + KSWZ(r32, (dd * 16 + hi * 8) * 2);
#pragma unroll
    for (int d0 = 0; d0 < 8; ++d0) { const char* a = kb[d0 & 3] + (d0 >> 2) * 128;
        bf16x8 b0 = *reinterpret_cast<const bf16x8*>(a);
        bf16x8 b1 = *reinterpret_cast<const bf16x8*>(a + 32 * 256);
        const bf16x8 qf = *reinterpret_cast<const bf16x8*>(qlds + d0 * 1024);
        p0 = __builtin_amdgcn_mfma_f32_32x32x16_bf16(b0, qf, p0, 0, 0, 0);
        p1 = __builtin_amdgcn_mfma_f32_32x32x16_bf16(b1, qf, p1, 0, 0, 0); }
}
template <int VB, bool SK>
__device__ __forceinline__ void pv_tile(f32x16* o, int vb0, bf16x8 pa0, bf16x8 pa1, bf16x8 pa2, bf16x8 pa3, bool act) {
    if (SK && !act) return;
#define TRRD(dst, off) asm volatile("ds_read_b64_tr_b16 %0, %1 offset:%2" : "=&v"(dst) : "v"(vb0), "i"(off) : "memory")
#define PV_D0(d0) do { s16x4 l0, l1, l2, l3, h0, h1, h2, h3; constexpr int b_ = VB * SHM_V + v_rd_off(d0, 0, 0);     \
        TRRD(l0, b_); TRRD(h0, b_ + 2048); TRRD(l1, b_ + 4096); TRRD(h1, b_ + 6144); TRRD(l2, b_ + 8192); TRRD(h2, b_ + 10240); TRRD(l3, b_ + 12288); TRRD(h3, b_ + 14336); \
        asm volatile("s_waitcnt lgkmcnt(0)" ::: "memory"); SBAR();                 \
        o[d0] = __builtin_amdgcn_mfma_f32_32x32x16_bf16(pa0, (bf16x8){l0[0], l0[1], l0[2], l0[3], h0[0], h0[1], h0[2], h0[3]}, o[d0], 0, 0, 0);   \
        o[d0] = __builtin_amdgcn_mfma_f32_32x32x16_bf16(pa1, (bf16x8){l1[0], l1[1], l1[2], l1[3], h1[0], h1[1], h1[2], h1[3]}, o[d0], 0, 0, 0);   \
        o[d0] = __builtin_amdgcn_mfma_f32_32x32x16_bf16(pa2, (bf16x8){l2[0], l2[1], l2[2], l2[3], h2[0], h2[1], h2[2], h2[3]}, o[d0], 0, 0, 0);   \
        o[d0] = __builtin_amdgcn_mfma_f32_32x32x16_bf16(pa3, (bf16x8){l3[0], l3[1], l3[2], l3[3], h3[0], h3[1], h3[2], h3[3]}, o[d0], 0, 0, 0); } while (0)
    PV_D0(0); PV_D0(1); PV_D0(2); PV_D0(3);
#undef PV_D0
#undef TRRD
}

template <class TIn, class TOut> struct BlockRef { const TIn* Q; const TIn* K; const TIn* V; TOut* O; int P0; };
template <class TIn> struct Seam {
    bf16x8 qr[8];
    bf16x8 st_v0, st_v1, st_k0, st_k1; f32x4 sf0, sf1, sf2, sf3;
    f32x4 tq[16];
};
__device__ __forceinline__ int swa_jlo(int P0, int W) { const int lowk = P0 - W + 1; return lowk > 0 ? lowk / KVBLK : 0; }
#define ROW(p, k0, rr) ((p) + (size_t)((k0) + (rr)) * LDR + sc)
#define VMW() asm volatile("s_waitcnt vmcnt(0)" ::: "memory")
#define VMWN(n) asm volatile("s_waitcnt vmcnt(%0)" :: "i"(n) : "memory")
#define SLOAD_H(Kp, Vp, k0) do { S.st_v0 = load8<TIn>(ROW(Vp, k0, sr)); S.st_v1 = load8<TIn>(ROW(Vp, k0, 32 + sr));              \
                         S.st_k0 = load8<TIn>(ROW(Kp, k0, sr)); S.st_k1 = load8<TIn>(ROW(Kp, k0, 32 + sr)); } while (0)
#define SWRITE_HK(bf) do { *(bf16x8*)(K_lds + (bf) * SHM_K + kws) = S.st_k0; *(bf16x8*)(K_lds + (bf) * SHM_K + kws + 32 * 256) = S.st_k1; } while (0)
#define SWRITE_HV(bf) do { *(bf16x8*)(V_lds + (bf) * SHM_V + vst0) = S.st_v0; *(bf16x8*)(V_lds + (bf) * SHM_V + vst1) = S.st_v1; } while (0)
#define SWRITE_H(bf) do { SWRITE_HV(bf); SWRITE_HK(bf); } while (0)
#define SLOAD_F(p, k0) do { S.sf0 = *(const f32x4*)ROW(p, k0, sr); S.sf1 = *(const f32x4*)(ROW(p, k0, sr) + 4);                \
                            S.sf2 = *(const f32x4*)ROW(p, k0, 32 + sr); S.sf3 = *(const f32x4*)(ROW(p, k0, 32 + sr) + 4); } while (0)
#define SWRITE_KF(bf) do { *(bf16x8*)(K_lds + (bf) * SHM_K + kws) = pack8(S.sf0, S.sf1); *(bf16x8*)(K_lds + (bf) * SHM_K + kws + 32 * 256) = pack8(S.sf2, S.sf3); } while (0)
#define SWRITE_VF(bf) do { *(bf16x8*)(V_lds + (bf) * SHM_V + vst0) = pack8(S.sf0, S.sf1); *(bf16x8*)(V_lds + (bf) * SHM_V + vst1) = pack8(S.sf2, S.sf3); } while (0)
template <class TIn, class TOut>
__device__ __forceinline__ void causal_swa_prime(const BlockRef<TIn, TOut>& cur, int W, char* lds, Seam<TIn>& S) {
    constexpr bool F32 = same_t<TIn, float>::v;
    const int tid = threadIdx.x, wid = __builtin_amdgcn_readfirstlane(tid >> 6), lane = tid & 63, r32 = lane & 31, hi = lane >> 5;
    const int sr = tid >> 4, sc = (tid & 15) * 8, kws = KSWZ(sr, sc * 2); char* K_lds = lds + 2 * SHM_V;
    const int kb0 = swa_jlo(cur.P0, W) * KVBLK;
    for (int d0 = 0; d0 < 8; ++d0) S.qr[d0] = load8<TIn>(cur.Q + (size_t)(wid * QBLK + r32) * LDR + d0 * 16 + hi * 8);
    if constexpr (F32) { SLOAD_F((const float*)cur.K, kb0); VMW(); SWRITE_KF(0); SBAR(); SLOAD_F((const float*)cur.V, kb0); }
    else { SLOAD_H(cur.K, cur.V, kb0); VMW(); SWRITE_HK(0); }
    __syncthreads();
}
template <class TIn, class TOut>
__device__ __forceinline__ void causal_swa_block(const BlockRef<TIn, TOut>& cur, const BlockRef<TIn, TOut>& nxt, int skv, int W, char* lds, Seam<TIn>& S, const float* nb) {
    constexpr bool F32 = same_t<TIn, float>::v;
    const int tid = threadIdx.x, wid = __builtin_amdgcn_readfirstlane(tid >> 6), lane = tid & 63, r32 = lane & 31, hi = lane >> 5;
    const int j_lo = swa_jlo(cur.P0, W);
    int j_hi = (cur.P0 + QB - 1) / KVBLK + 1; if (j_hi > skv / KVBLK) j_hi = skv / KVBLK;
    const int NT = j_hi - j_lo;
    const int kbn = swa_jlo(nxt.P0, W) * KVBLK;
    const int qlo = cur.P0 + wid * QBLK, qm = qlo + r32 - 4 * hi;
    char* V_lds = lds; char* K_lds = lds + 2 * SHM_V;
    float* ws = (float*)(lds + 2 * SHM_V + 2 * SHM_K) + wid * 64; float* li_l = ws, * al_l = ws + 32;
    float m_reg = -1e30f, l_reg = 0; f32x16 o[4] = {};
    const float mfloor = __builtin_bit_cast(float, __builtin_amdgcn_readfirstlane(__builtin_bit_cast(int, nb[cur.P0 + wid * QBLK])));
    const int sr = tid >> 4, sc = (tid & 15) * 8, vst0 = v_st(sr, sc), vst1 = v_st(32 + sr, sc), kws = KSWZ(sr, sc * 2);
    const int vb0 = (int)(uintptr_t)V_lds + v_rd_base(lane);
    const TIn* Kh = cur.K; const TIn* Vh = cur.V;
#define RESC(a) do { if (__any((a) < 1.f)) { if (hi == 0) al_l[r32] = (a); asm volatile("s_waitcnt lgkmcnt(0)" ::: "memory");              \
                     for (int d_ = 0; d_ < 4; ++d_) for (int r = 0; r < 16; ++r) o[d_][r] *= al_l[crow(r, hi)]; } } while (0)
#define KBASE(t) ((j_lo + (t)) * KVBLK)
#define ACT(t) (KBASE(t) <= qlo + QBLK - 1 && KBASE(t) + KVBLK - 1 >= qlo - W + 1)
#define MASKT(P0_, P1_, t) do { const int kb_ = KBASE(t); if ((!SK || ACT(t)) && (kb_ + KVBLK - 1 > qlo || kb_ <= qlo + QBLK - 1 - W)) mask_tile(P0_, P1_, qm - kb_, (unsigned)W); } while (0)
    constexpr int NQL = F32 ? 16 : 8;
    constexpr bool SK = WSKIP && !F32;
#define SEAM_K0() do { VMWN(NQL); if constexpr (F32) { SWRITE_KF(0); SBAR(); SLOAD_F((const float*)nxt.V, kbn); } else { SWRITE_HK(0); } SBAR(); } while (0)
    f32x16 pA0, pA1, pB0, pB1; float mnA, mnB, alA, alB; bf16x8 pa0, pa1, pa2, pa3;
    if constexpr (F32) { VMW(); SWRITE_VF(0); SBAR(); } else { SWRITE_HV(0); SBAR(); }
    char* qlds = lds + QLDS_OFF + wid * 8192 + lane * 16;
    { _Pragma("unroll") for (int d0 = 0; d0 < 8; ++d0) *reinterpret_cast<bf16x8*>(qlds + d0 * 1024) = S.qr[d0]; }
    SBAR();
    if (NT > 1) { if constexpr (F32) SLOAD_F((const float*)Kh, KBASE(1)); else SLOAD_H(Kh, Vh, KBASE(1)); }
    SBAR(); qkt<0, SK>(pA0, pA1, K_lds, r32, hi, qlds, ACT(0), nb + KBASE(0) + 4 * hi);
    if constexpr (F32) { if (NT > 1) { VMW(); SWRITE_KF(1); SBAR(); SLOAD_F((const float*)Vh, KBASE(1)); } }
    MASKT(pA0, pA1, 0); partialSM(pA0, pA1, m_reg, mnA, alA, mfloor);
    if (NT > 1) { VMW(); if constexpr (F32) { SWRITE_VF(1); SBAR(); if (NT > 2) SLOAD_F((const float*)Kh, KBASE(2)); } else SWRITE_H(1); }
    __syncthreads();
#define HALF_STEP(PX0, PX1, mnX, alX, PY0, PY1, alY, t, KB, VB, SB) do {                                                      \
        SBAR(); qkt<KB, SK>(PX0, PX1, K_lds, r32, hi, qlds, ACT(t), nb + KBASE(t) + 4 * hi);                                             \
        finishSM(PY0, PY1, alY, l_reg, pa0, pa1, pa2, pa3); SBAR();                                                           \
        if ((t) + 1 < NT) { if constexpr (F32) { VMW(); SWRITE_KF(SB); SBAR(); SLOAD_F((const float*)Vh, KBASE((t) + 1)); }  \
                            else { SLOAD_H(Kh, Vh, KBASE((t) + 1)); } SBAR(); }                                               \
        pv_tile<VB, SK>(o, vb0, pa0, pa1, pa2, pa3, ACT((t) - 1)); MASKT(PX0, PX1, (t)); partialSM(PX0, PX1, m_reg, mnX, alX, mfloor);                                        \
        __syncthreads();                                                                                                      \
        if ((t) + 1 < NT) { VMW(); if constexpr (F32) { SWRITE_VF(SB); SBAR(); if ((t) + 2 < NT) SLOAD_F((const float*)Kh, KBASE((t) + 2)); } \
                            else { SWRITE_H(SB); } }                                                                          \
        RESC(alX); __syncthreads(); } while (0)
    for (int t = 1; t + 1 < NT; t += 2) {
        HALF_STEP(pB0, pB1, mnB, alB, pA0, pA1, alA, t, 1, 0, 0);
        HALF_STEP(pA0, pA1, mnA, alA, pB0, pB1, alB, t + 1, 0, 1, 1);
    }
    const bool even = (NT & 1) == 0;
    if (even) { SBAR(); qkt<1, SK>(pB0, pB1, K_lds, r32, hi, qlds, ACT(NT - 1), nb + KBASE(NT - 1) + 4 * hi); SBAR(); }
#define QROW(e) (nxt.Q + (size_t)(wid * QBLK + r32) * LDR + ((e) >> 1) * 16 + hi * 8 + ((e) & 1) * 4)
    if constexpr (F32) { SLOAD_F((const float*)nxt.K, kbn); SBAR();
#pragma unroll
        for (int e = 0; e < 8; ++e) S.tq[e] = *(const f32x4*)QROW(e); }
    else { SLOAD_H(nxt.K, nxt.V, kbn); SBAR();
#pragma unroll
        for (int d0 = 0; d0 < 8; ++d0) S.qr[d0] = load8<TIn>(nxt.Q + (size_t)(wid * QBLK + r32) * LDR + d0 * 16 + hi * 8); }
    SBAR();
    finishSM(pA0, pA1, alA, l_reg, pa0, pa1, pa2, pa3); SBAR();
    if constexpr (F32) {
#pragma unroll
        for (int e = 8; e < 16; ++e) S.tq[e] = *(const f32x4*)QROW(e); SBAR(); }
#undef QROW
    pv_tile<0, SK>(o, vb0, pa0, pa1, pa2, pa3, ACT(even ? NT - 2 : NT - 1));
    if (even) { MASKT(pB0, pB1, NT - 1); partialSM(pB0, pB1, m_reg, mnB, alB, mfloor); __syncthreads(); RESC(alB);
        finishSM(pB0, pB1, alB, l_reg, pa0, pa1, pa2, pa3); SBAR(); pv_tile<1, SK>(o, vb0, pa0, pa1, pa2, pa3, ACT(NT - 1)); }
    SBAR(); SEAM_K0();
    if (hi == 0) li_l[r32] = l_reg; asm volatile("s_waitcnt lgkmcnt(0)" ::: "memory");
    float rli[16];
#pragma unroll
    for (int r = 0; r < 16; ++r) rli[r] = __builtin_amdgcn_rcpf(li_l[crow(r, hi)]);
    TOut* Ow = cur.O + (size_t)(wid * QBLK) * LDR;
#pragma unroll
    for (int r = 0; r < 16; ++r) { const int orow = crow(r, hi);
#pragma unroll
        for (int d0 = 0; d0 < 4; ++d0) { const float v = o[d0][r] * rli[r];
            if constexpr (same_t<TOut, float>::v) { Ow[(size_t)orow * LDR + d0 * 32 + r32] = v; }
            else { const float vn = __shfl_xor(v, 1);
                   if ((r32 & 1) == 0) *(unsigned*)(Ow + (size_t)orow * LDR + d0 * 32 + r32) = cvtpk(v, vn); } } }
    if constexpr (F32) {
#pragma unroll
        for (int d0 = 0; d0 < 8; ++d0) S.qr[d0] = pack8(S.tq[2 * d0], S.tq[2 * d0 + 1]); }
    __syncthreads();
#undef RESC
#undef KBASE
#undef ACT
#undef MASKT
#undef SEAM_K0
#undef HALF_STEP
}
#undef ROW
#undef VMW
#undef VMWN
#undef SLOAD_H
#undef SWRITE_HK
#undef SWRITE_HV
#undef SWRITE_H
#undef SLOAD_F
#undef SWRITE_KF
#undef SWRITE_VF

}
constexpr int M_TOK = 8192, DMODEL = 2048, DFF = 8192, SEQ = 2048, NBATCH = 4, NHEAD = 16, HDIM = 128, PLE = 256;
constexpr int NWAVES = 8, NTHREADS = 512;
constexpr int LDS_BYTES = 147456;
constexpr int LDS_MISC_OFF = 147456 - 64;
#define LAS __attribute__((address_space(3)))
typedef unsigned short bf16_t;
typedef float f32x4 __attribute__((ext_vector_type(4)));
typedef unsigned v4u __attribute__((ext_vector_type(4)));
typedef unsigned v2u __attribute__((ext_vector_type(2)));

constexpr size_t MiB = 1u << 20;
constexpr size_t WS_SS = 1536 * 1024;
constexpr size_t WS_RS0 = 256 * 1024;
constexpr size_t WS_LB = 320 * 1024;
constexpr size_t WS_BAR = 512 * 1024;
constexpr size_t WS_FL = 1 * MiB;
constexpr size_t WS_WUP0 = 2 * MiB, WS_WDN0 = 34 * MiB, WS_WG0 = 66 * MiB, WS_WPU = 74 * MiB;
constexpr size_t WS_HB0 = 76 * MiB, WS_HB1 = 108 * MiB, WS_PU = 140 * MiB;
constexpr size_t WS_B = 204 * MiB;
constexpr size_t WS_WIN = WS_B, WS_WAOUT = WS_B + 32 * MiB, WS_XB = WS_B + 40 * MiB, WS_OG = WS_XB, WS_QIN = WS_B + 72 * MiB, WS_KIN = WS_B + 104 * MiB, WS_KEND = WS_B + 136 * MiB,
                 WS_V0 = WS_B + 168 * MiB, WS_SG = WS_B + 200 * MiB, WS_PB = WS_B + 232 * MiB, WS_DEC = WS_B + 240 * MiB;
constexpr size_t WS_HID = WS_B, WS_WG1 = WS_B + 192 * MiB, WS_WKVQ = WS_B + 200 * MiB, WS_WBOUT = WS_B + 224 * MiB;
constexpr size_t WS_WUP1 = WS_B + 244 * MiB, WS_WDN1 = WS_B + 276 * MiB;
constexpr size_t WS_KB = WS_B, WS_VB = WS_B + 32 * MiB, WS_QB = WS_B + 64 * MiB, WS_AO = WS_B + 96 * MiB;
constexpr size_t WS_END = WS_B + 308 * MiB;

struct Params { const float* in[19]; float* out; unsigned char* ws; int ph_lo, ph_hi, coop, pad; };
enum { I_X = 0, I_P, I_MIXN, I_MLPN, I_PLEN, I_WAIN, I_LBL, I_HGAIN, I_WAOUT, I_KVN, I_WKVF, I_BF, I_WBQ, I_WBOUT, I_WUP, I_WDN, I_WG, I_WPU, I_FINN };

__device__ __forceinline__ float wave_sum(float v) {
#pragma unroll
    for (int o = 1; o < 64; o <<= 1) v += __shfl_xor(v, o);
    return v;
}
__device__ __forceinline__ unsigned f2bf(float f) { unsigned u = __builtin_bit_cast(unsigned, f); return (u + 0x7fffu + ((u >> 16) & 1u)) >> 16; }
__device__ __forceinline__ unsigned pk2(float lo, float hi) { return f2bf(lo) | (f2bf(hi) << 16); }
__device__ __forceinline__ float bf2f(bf16_t v) { return __uint_as_float((unsigned)v << 16); }

__device__ __forceinline__ void tr_load(const float* W, int ld, const float* gain, int gmask, int k0, int n0, int lane, float (&v)[32]) {
#pragma unroll
    for (int i = 0; i < 32; ++i) { const int kk = 2 * i + (lane >> 5); v[i] = __builtin_nontemporal_load(W + (size_t)(k0 + kk) * ld + n0 + (lane & 31)); }
    (void)gain; (void)gmask;
}
__device__ __forceinline__ void tr_put(LAS float* scr, int lane, const float (&v)[32]) {
#pragma unroll
    for (int i = 0; i < 32; ++i) { const int kk = 2 * i + (lane >> 5); scr[kk * 33 + (lane & 31)] = v[i]; }
    asm volatile("s_waitcnt lgkmcnt(0)" ::: "memory");
}
__device__ __forceinline__ void tr_out(bf16_t* WT, int K, int drow0, LAS float* scr, int k0, int lane, const float* gain, int gmask) {
    const int c = lane & 7;
    f32x4 g0 = (f32x4){1.f, 1.f, 1.f, 1.f}, g1 = g0;
    if (gain) { const float* gp = gain + ((k0 + 8 * c) & gmask); g0 = *(const f32x4*)gp; g1 = *(const f32x4*)(gp + 4); }
#pragma unroll
    for (int j = 0; j < 4; ++j) { const int n = (lane >> 3) + 8 * j; const LAS float* s = scr + (8 * c) * 33 + n;
        v4u o; o.x = pk2(s[0 * 33] * g0[0], s[1 * 33] * g0[1]); o.y = pk2(s[2 * 33] * g0[2], s[3 * 33] * g0[3]); o.z = pk2(s[4 * 33] * g1[0], s[5 * 33] * g1[1]); o.w = pk2(s[6 * 33] * g1[2], s[7 * 33] * g1[3]);
        __builtin_nontemporal_store(o, (v4u*)(WT + (size_t)(drow0 + n) * K + k0 + 8 * c)); }
    asm volatile("s_waitcnt lgkmcnt(0)" ::: "memory");
}
template <int MODE = 0>
__device__ __forceinline__ void tr_job(const float* W, int K, int N, int ld, const float* gain, int gmask, bf16_t* WT, int drow_off, LAS float* scr, int gw, int NGW, int lane) {
    const int nblk = N / 32, nitems = (K / 64) * nblk;
    float v[32];
    int it = gw;
    if (it < nitems) { const int kb = it / nblk, nb = it - kb * nblk; tr_load(W, ld, gain, gmask, 64 * kb, 32 * nb, lane, v); }
    for (; it < nitems; it += NGW) { const int kb = it / nblk, nb = it - kb * nblk; const int n0 = 32 * nb; int drow = drow_off + n0;
        if (MODE == 1) { const int r = n0 >> 11, hh = (n0 >> 7) & 15, dd = n0 & 127; drow = 256 * (2 * hh + ((r >> 1) ^ ((hh >> 1) & 1))) + 128 * (r & 1) + dd; }
        tr_put(scr, lane, v);
        const int itn = it + NGW;
        if (itn < nitems) { const int kbn = itn / nblk, nbn = itn - kbn * nblk; tr_load(W, ld, gain, gmask, 64 * kbn, 32 * nbn, lane, v); }
        tr_out(WT, K, drow, scr, 64 * kb, lane, gain, gmask); }
}

__device__ __forceinline__ void phase_prologue(const Params& P, LAS unsigned char* lds) {
    const int tid = threadIdx.x, lane = tid & 63, wave = tid >> 6; const int gw = blockIdx.x * NWAVES + wave, NGW = gridDim.x * NWAVES;
    LAS float* scr = (LAS float*)(lds + wave * 16384);
    unsigned char* ws = P.ws;
    tr_job<1>(P.in[I_WAIN], 2048, 8192, 8192, P.in[I_MIXN], 0x7fffffff, (bf16_t*)(ws + WS_WIN), 0, scr, gw, NGW, lane);
    tr_job(P.in[I_WPU], 256, 2048, 2048, nullptr, 0, (bf16_t*)(ws + WS_WPU), 0, scr, gw, NGW, lane);
    tr_job(P.in[I_WPU] + 256 * 2048, 256, 2048, 2048, nullptr, 0, (bf16_t*)(ws + WS_WPU) + 2048 * 256, 0, scr, gw, NGW, lane);
    const float* x = P.in[I_X]; bf16_t* xb = (bf16_t*)(ws + WS_XB); float* rs0 = (float*)(ws + WS_RS0);
    for (int r = gw; r < M_TOK; r += NGW) { const f32x4* xr = (const f32x4*)(x + (size_t)r * DMODEL) + lane; float s = 0.f; f32x4 v[8];
#pragma unroll
        for (int j = 0; j < 8; ++j) { v[j] = __builtin_nontemporal_load(xr + 64 * j); s += (v[j][0] * v[j][0] + v[j][1] * v[j][1]) + (v[j][2] * v[j][2] + v[j][3] * v[j][3]); }
        s = wave_sum(s); if (lane == 0) rs0[r] = rsqrtf(s * (1.0f / 2048.0f) + 1e-6f);
        v2u* o = (v2u*)(xb + (size_t)r * DMODEL) + lane;
#pragma unroll
        for (int j = 0; j < 8; ++j) { v2u w; w.x = pk2(v[j][0], v[j][1]); w.y = pk2(v[j][2], v[j][3]); o[64 * j] = w; } }
    const int gt = blockIdx.x * NTHREADS + tid, NGT = gridDim.x * NTHREADS;
    { const f32x4* p4 = (const f32x4*)P.in[I_P]; v2u* pb = (v2u*)(ws + WS_PB);
      for (int i = gt; i < 2 * M_TOK * PLE / 4; i += NGT) { const f32x4 v = __builtin_nontemporal_load(p4 + i); v2u w; w.x = pk2(v[0], v[1]); w.y = pk2(v[2], v[3]); pb[i] = w; } }
    { const float* l = P.in[I_LBL]; float* lb = (float*)(ws + WS_LB); for (int i = gt; i < DMODEL; i += NGT) lb[i] = 1.0f / (1.0f + __expf(l[DMODEL + i] - l[i])); }
    { long long* ss = (long long*)(ws + WS_SS); for (int i = gt; i < 6 * M_TOK; i += NGT) ss[i] = 0ll; }
}
__device__ __forceinline__ void phase_weights1(const Params& P, LAS unsigned char* lds) {
    const int tid = threadIdx.x, lane = tid & 63, wave = tid >> 6; const int gw = blockIdx.x * NWAVES + wave, NGW = gridDim.x * NWAVES;
    LAS float* scr = (LAS float*)(lds + wave * 16384);
    unsigned char* ws = P.ws;
    tr_job(P.in[I_WG] + (size_t)2048 * 2048, 2048, 2048, 2048, P.in[I_PLEN] + 2048, 0x7fffffff, (bf16_t*)(ws + WS_WG1), 0, scr, gw, NGW, lane);
    asm volatile("s_waitcnt vmcnt(0) lgkmcnt(0)" ::: "memory"); __syncthreads();
}

typedef short s16x4 __attribute__((ext_vector_type(4)));
typedef short s16x8 __attribute__((ext_vector_type(8)));
constexpr int SC_RS = 264, SC_TILE = 16 * SC_RS, SC_CH = 5 * SC_TILE + 512, SC_G = 2, SC_BUF = SC_G * SC_CH, SC_SP = 2 * SC_BUF  , SC_KT = SC_SP + 1024  ;
typedef float f32x2_t __attribute__((ext_vector_type(2))); typedef __bf16 bf16x2_t __attribute__((ext_vector_type(2)));
__device__ __forceinline__ unsigned cvtpk_bf16(float lo, float hi) { f32x2_t v = {lo, hi}; bf16x2_t b = __builtin_convertvector(v, bf16x2_t); return __builtin_bit_cast(unsigned, b); }
template <int CTRL> __device__ __forceinline__ float sc_dpp(float x) { return __builtin_bit_cast(float, __builtin_amdgcn_update_dpp(0, __builtin_bit_cast(int, x), CTRL, 0xf, 0xf, true)); }
__device__ __forceinline__ void phase_scan(const Params& P, LAS unsigned char* lds) {
    const int tid = threadIdx.x, lane = tid & 63, w = __builtin_amdgcn_readfirstlane(tid >> 6), l15 = lane & 15, kg = lane >> 4;
    unsigned char* ws = P.ws;
    const int nscan = NBATCH * NHEAD;
    const bool split = (int)gridDim.x > nscan;
    if (!split || (int)blockIdx.x < nscan) {
        const bf16_t* QIN = (const bf16_t*)(ws + WS_QIN); const bf16_t* KIN = (const bf16_t*)(ws + WS_KIN);
        const bf16_t* V0 = (const bf16_t*)(ws + WS_V0); const bf16_t* SG = (const bf16_t*)(ws + WS_SG); const float* DEC = (const float*)(ws + WS_DEC);
        bf16_t* OG = (bf16_t*)P.out;
        const int stok = tid >> 5, d4 = (tid & 31) * 4;
        LAS float* sp = (LAS float*)(lds + SC_SP);
        for (int item = blockIdx.x; item < nscan; item += (split ? nscan : (int)gridDim.x)) {
            const int b = item >> 4, h = item & 15;
            f32x4 S[8];
#pragma unroll
            for (int dt = 0; dt < 8; ++dt) S[dt] = (f32x4){0.f, 0.f, 0.f, 0.f};
            v2u rq[2][SC_G], rk[2][SC_G], rv[2][SC_G], rg[2][SC_G]; float rd[2][SC_G];
#define SC_LOAD(st, g) do { _Pragma("unroll") for (int c2 = 0; c2 < SC_G; ++c2) { const int ch = b * 128 + (g) * SC_G + c2; const size_t off = (size_t)(ch * 16 + stok) * DMODEL + h * HDIM + d4; \
                rq[st][c2] = __builtin_nontemporal_load((const v2u*)(QIN + off)); rk[st][c2] = __builtin_nontemporal_load((const v2u*)(KIN + off)); rv[st][c2] = __builtin_nontemporal_load((const v2u*)(V0 + off)); rg[st][c2] = __builtin_nontemporal_load((const v2u*)(SG + off)); \
                rd[st][c2] = (tid < 128) ? DEC[(size_t)ch * DMODEL + h * HDIM + tid] : 0.f; } } while (0)
#define SC_WRITE(st, bi) do { _Pragma("unroll") for (int c2 = 0; c2 < SC_G; ++c2) { LAS unsigned char* cbw = lds + (bi) * SC_BUF + c2 * SC_CH + stok * SC_RS + d4 * 2; \
                *(LAS v2u*)(cbw) = rq[st][c2]; *(LAS v2u*)(cbw + SC_TILE) = rk[st][c2]; *(LAS v2u*)(cbw + 3 * SC_TILE) = rv[st][c2]; *(LAS v2u*)(cbw + 4 * SC_TILE) = rg[st][c2]; \
                if (tid < 128) *(LAS float*)(lds + (bi) * SC_BUF + c2 * SC_CH + 5 * SC_TILE + tid * 4) = rd[st][c2]; } } while (0)
            SC_LOAD(0, 0); SC_WRITE(0, 0); SC_LOAD(1, 1); SC_LOAD(0, 2);
            __syncthreads();
            constexpr int NG = (SEQ / 16) / SC_G;
            for (int g2 = 0; g2 < NG; g2 += 2) {
#pragma unroll
              for (int par = 0; par < 2; ++par) { const int g = g2 + par;
#pragma unroll
                for (int cc = 0; cc < SC_G; ++cc) {
                    const int n = g * SC_G + cc;
                    const LAS unsigned char* cb = lds + par * SC_BUF + cc * SC_CH;
                    s16x8 qA[4], kA[4];
#pragma unroll
                    for (int ks = 0; ks < 4; ++ks) { const LAS unsigned char* p = cb + l15 * SC_RS + (32 * ks + 4 * kg) * 2;
                        const v2u qlo = *(const LAS v2u*)p, qhi = *(const LAS v2u*)(p + 32), klo = *(const LAS v2u*)(p + SC_TILE), khi = *(const LAS v2u*)(p + SC_TILE + 32);
                        qA[ks] = __builtin_bit_cast(s16x8, (v4u){qlo.x, qlo.y, qhi.x, qhi.y}); kA[ks] = __builtin_bit_cast(s16x8, (v4u){klo.x, klo.y, khi.x, khi.y}); }
                    s16x8 vB = (s16x8){0, 0, 0, 0, 0, 0, 0, 0};
#pragma unroll
                    for (int j = 0; j < 4; ++j) vB[j] = *(const LAS short*)(cb + 3 * SC_TILE + (4 * kg + j) * SC_RS + (16 * w + l15) * 2);
                    const f32x4 z4 = (f32x4){0.f, 0.f, 0.f, 0.f};
                    f32x4 at0 = __builtin_amdgcn_mfma_f32_16x16x32_bf16(kA[0], qA[0], z4, 0, 0, 0);
                    f32x4 at1 = __builtin_amdgcn_mfma_f32_16x16x32_bf16(kA[1], qA[1], z4, 0, 0, 0);
                    s16x8 Sb[4];
#pragma unroll
                    for (int ks = 0; ks < 4; ++ks) Sb[ks] = __builtin_bit_cast(s16x8, (v4u){cvtpk_bf16(S[2 * ks][0], S[2 * ks][1]), cvtpk_bf16(S[2 * ks][2], S[2 * ks][3]),
                                                                                           cvtpk_bf16(S[2 * ks + 1][0], S[2 * ks + 1][1]), cvtpk_bf16(S[2 * ks + 1][2], S[2 * ks + 1][3])});
                    f32x4 os0 = __builtin_amdgcn_mfma_f32_16x16x32_bf16(qA[0], Sb[0], z4, 0, 0, 0);
                    f32x4 os1 = __builtin_amdgcn_mfma_f32_16x16x32_bf16(qA[1], Sb[1], z4, 0, 0, 0);
                    at0 = __builtin_amdgcn_mfma_f32_16x16x32_bf16(kA[2], qA[2], at0, 0, 0, 0);
                    at1 = __builtin_amdgcn_mfma_f32_16x16x32_bf16(kA[3], qA[3], at1, 0, 0, 0);
                    os0 = __builtin_amdgcn_mfma_f32_16x16x32_bf16(qA[2], Sb[2], os0, 0, 0, 0);
                    os1 = __builtin_amdgcn_mfma_f32_16x16x32_bf16(qA[3], Sb[3], os1, 0, 0, 0);
                    f32x4 at = at0 + at1;
#pragma unroll
                    for (int i = 0; i < 4; ++i) if (4 * kg + i > l15) at[i] = 0.f;
                    const s16x8 attA = __builtin_bit_cast(s16x8, (v4u){cvtpk_bf16(at[0], at[1]), cvtpk_bf16(at[2], at[3]), 0u, 0u});
                    const f32x4 o = __builtin_amdgcn_mfma_f32_16x16x32_bf16(attA, vB, os0 + os1, 0, 0, 0);
                    { s16x4 kf;
#pragma unroll
                      for (int j = 0; j < 4; ++j) kf[j] = *(const LAS short*)(cb + 1 * SC_TILE + (4 * kg + j) * SC_RS + (16 * w + l15) * 2);
                      *(LAS s16x4*)(lds + SC_KT + ((n & 1) * 8 + w) * 512 + lane * 8) = kf; }
                    f32x4 sq = o * o;
#pragma unroll
                    for (int i = 0; i < 4; ++i) { float x = sq[i]; x += sc_dpp<0xB1>(x); x += sc_dpp<0x4E>(x); x += sc_dpp<0x141>(x); x += sc_dpp<0x140>(x); sq[i] = x; }
                    if (l15 == 0) *(LAS f32x4*)(sp + ((n & 1) * 8 + w) * 16 + kg * 4) = sq;
                    if (cc == SC_G - 1 && g + 1 < NG) SC_WRITE(1 - par, 1 - par);
                    __syncthreads();
                    f32x4 tot = (f32x4){0.f, 0.f, 0.f, 0.f};
#pragma unroll
                    for (int ww = 0; ww < 8; ++ww) tot += *(const LAS f32x4*)(sp + ((n & 1) * 8 + ww) * 16 + kg * 4);
#pragma unroll
                    for (int dt = 0; dt < 8; ++dt) { s16x8 keA = (s16x8){0, 0, 0, 0, 0, 0, 0, 0};
                        const s16x4 kf = *(const LAS s16x4*)(lds + SC_KT + ((n & 1) * 8 + dt) * 512 + lane * 8);
                        keA[0] = kf[0]; keA[1] = kf[1]; keA[2] = kf[2]; keA[3] = kf[3];
                        const f32x4 dc = *(const LAS f32x4*)(cb + 5 * SC_TILE + (16 * dt + 4 * kg) * 4);
                        S[dt] = __builtin_amdgcn_mfma_f32_16x16x32_bf16(keA, vB, S[dt], 0, 0, 0) * dc; }
                    const int tok0 = (b * 128 + n) * 16;
#pragma unroll
                    for (int i = 0; i < 4; ++i) { const float r = rsqrtf(tot[i] * (1.0f / 128.0f) + 1e-6f);
                        const bf16_t gv = *(const LAS bf16_t*)(cb + 4 * SC_TILE + (4 * kg + i) * SC_RS + (16 * w + l15) * 2);
                        OG[(size_t)(tok0 + 4 * kg + i) * DMODEL + h * HDIM + 16 * w + l15] = (bf16_t)f2bf(o[i] * r * bf2f(gv)); }
                    if (cc == SC_G - 1 && g + 3 < NG) SC_LOAD(1 - par, g + 3);
                }
              }
            }
            __syncthreads();
#undef SC_LOAD
#undef SC_WRITE
        }
    }
    if (!split || (int)blockIdx.x >= nscan) {
        const int nconv = split ? (int)gridDim.x - nscan : (int)gridDim.x, cid = split ? (int)blockIdx.x - nscan : (int)blockIdx.x;
        const int gw = cid * NWAVES + w, NGW = nconv * NWAVES; LAS float* scr = (LAS float*)(lds + w * 16384);
        tr_job(P.in[I_WAOUT], 2048, 2048, 2048, P.in[I_HGAIN], 127, (bf16_t*)(ws + WS_WAOUT), 0, scr, gw, NGW, lane);
        tr_job(P.in[I_WUP], 2048, 8192, 8192, P.in[I_MLPN], 0x7fffffff, (bf16_t*)(ws + WS_WUP0), 0, scr, gw, NGW, lane);
        tr_job(P.in[I_WDN], 8192, 2048, 2048, nullptr, 0, (bf16_t*)(ws + WS_WDN0), 0, scr, gw, NGW, lane);
        tr_job(P.in[I_WG], 2048, 2048, 2048, P.in[I_PLEN], 0x7fffffff, (bf16_t*)(ws + WS_WG0), 0, scr, gw, NGW, lane);
        tr_job(P.in[I_WUP] + (size_t)2048 * 8192, 2048, 8192, 8192, P.in[I_MLPN] + 2048, 0x7fffffff, (bf16_t*)(ws + WS_WUP1), 0, scr, gw, NGW, lane);
        tr_job(P.in[I_WDN] + (size_t)2048 * 8192, 8192, 2048, 2048, nullptr, 0, (bf16_t*)(ws + WS_WDN1), 0, scr, gw, NGW, lane);
        { bf16_t* WKVQ = (bf16_t*)P.out + (size_t)M_TOK * DMODEL; bf16_t* WBO = WKVQ + (size_t)6144 * 2048;
          tr_job(P.in[I_WKVF], 2048, 4096, 4112, P.in[I_KVN], 0x7fffffff, WKVQ, 0, scr, gw, NGW, lane);
          tr_job(P.in[I_WBQ], 2048, 2048, 2048, P.in[I_MIXN] + 2048, 0x7fffffff, WKVQ, 4096, scr, gw, NGW, lane);
          tr_job(P.in[I_WBOUT], 2048, 2048, 2048, nullptr, 0, WBO, 0, scr, gw, NGW, lane); }
        asm volatile("s_waitcnt vmcnt(0) lgkmcnt(0)" ::: "memory"); __syncthreads();
        for (int l = 0; l < 2; ++l) { pg8::Gemm g{(const bf16_t*)(ws + WS_PB) + (size_t)l * M_TOK * PLE, (const bf16_t*)(ws + WS_WPU) + (size_t)l * 2048 * 256, M_TOK, 2048, 256}; pg8::StaticOrder So; So.init(M_TOK, 2048, nconv, cid);
            pg8::EpiStore E{(bf16_t*)(ws + WS_PU) + (size_t)l * M_TOK * DMODEL, 0, nullptr};
            pg8::gemm_phase<pg8::EpiStore, pg8::StaticOrder, true, true>(lds, g, So, E); }
    }
    asm volatile("s_waitcnt vmcnt(0) lgkmcnt(0)" ::: "memory"); __syncthreads();
}

__device__ __forceinline__ void phase_flogit(const Params& P, LAS unsigned char* lds) {
    const int tid = threadIdx.x, lane = tid & 63, wave = tid >> 6; const int gw = blockIdx.x * NWAVES + wave, NGW = gridDim.x * NWAVES;
    const bf16_t* H = (const bf16_t*)(P.ws + WS_HB0); const pg8::ss_t* ss = (const pg8::ss_t*)(P.ws + WS_SS) + 2 * M_TOK; const float* kvn = P.in[I_KVN]; const float* W = P.in[I_WKVF]; const float* bf = P.in[I_BF];
    float* FL = (float*)(P.ws + WS_FL);
    LAS float* Wl = (LAS float*)lds;
    for (int idx = tid; idx < 2048 * 4; idx += NTHREADS) { const int k = idx >> 2, jq = idx & 3; const float g = kvn[k]; const f32x4 w = *(const f32x4*)(W + (size_t)k * 4112 + 4096 + 4 * jq);
#pragma unroll
        for (int i = 0; i < 4; ++i) Wl[(4 * jq + i) * 2048 + k] = w[i] * g; }
    __syncthreads();
    for (int r4 = gw; r4 < M_TOK / 4; r4 += NGW) {
        float acc[4][16];
#pragma unroll
        for (int a = 0; a < 4; ++a)
#pragma unroll
            for (int j = 0; j < 16; ++j) acc[a][j] = 0.f;
#pragma unroll 2
        for (int t = 0; t < 8; ++t) { const int k4 = 4 * lane + 256 * t; f32x4 hv[4];
#pragma unroll
            for (int a = 0; a < 4; ++a) { const v2u hw = __builtin_nontemporal_load((const v2u*)(H + (size_t)(4 * r4 + a) * DMODEL + k4));
                hv[a] = (f32x4){__uint_as_float(hw.x << 16), __uint_as_float(hw.x & 0xffff0000u), __uint_as_float(hw.y << 16), __uint_as_float(hw.y & 0xffff0000u)}; }
#pragma unroll
            for (int j = 0; j < 16; ++j) { const f32x4 w = *(const LAS f32x4*)(Wl + j * 2048 + k4);
#pragma unroll
                for (int a = 0; a < 4; ++a) acc[a][j] += (hv[a][0] * w[0] + hv[a][1] * w[1]) + (hv[a][2] * w[2] + hv[a][3] * w[3]); } }
#pragma unroll
        for (int a = 0; a < 4; ++a) { const int row = 4 * r4 + a; const float rs = pg8::ss_rs(ss, row); float mine = 0.f;
#pragma unroll
            for (int j = 0; j < 16; ++j) { const float v = wave_sum(acc[a][j]); if (lane == j) mine = v; }
            if (lane < 16) { const float xv = mine * rs + bf[lane]; const float ls = (xv >= 0.f) ? -log1pf(expf(-xv)) : (xv - log1pf(expf(xv)));
                const int b = row / SEQ, s = row - b * SEQ; FL[((size_t)(b * NHEAD + lane)) * SEQ + s] = ls; } }
    }
    __syncthreads();
}

constexpr int ATT_NB_OFF = 69632;
__device__ __forceinline__ void phase_attention(const Params& P, unsigned char* lds_g) {
    using namespace attn;
    const int tid = threadIdx.x, lane = tid & 63, wave = tid >> 6;
    const bf16* Q = (const bf16*)(P.ws + WS_QB); const bf16* K = (const bf16*)(P.ws + WS_KB); const bf16* V = (const bf16*)(P.ws + WS_VB); bf16* O = (bf16*)(P.ws + WS_AO);
    const float* FL = (const float*)(P.ws + WS_FL);
    float* nb = (float*)(lds_g + ATT_NB_OFF); float* wsum = nb + 2048;
    const int total = NBATCH * NHEAD * 4;
    for (int L = blockIdx.x; L < total; L += gridDim.x) {
        const int bh = L >> 2, y = L & 3, b = bh >> 4, h = bh & 15;
        { const f32x4 v = *(const f32x4*)(FL + (size_t)bh * SEQ + 4 * tid); float p0 = v[0], p1 = p0 + v[1], p2 = p1 + v[2], p3 = p2 + v[3];
          float incl = p3;
#pragma unroll
          for (int o = 1; o < 64; o <<= 1) { const float t = __shfl_up(incl, o); if (lane >= o) incl += t; }
          if (lane == 63) wsum[wave] = incl;
          __syncthreads();
          float base = incl - p3; for (int w = 0; w < wave; ++w) base += wsum[w];
          const float sc = -11.313708498984761f;
          *(f32x4*)(nb + 4 * tid) = (f32x4){(base + p0) * sc, (base + p1) * sc, (base + p2) * sc, (base + p3) * sc};
          __syncthreads(); }
        const size_t rowb = (size_t)b * SEQ * DMODEL + (size_t)h * HDIM;
        BlockRef<bf16, bf16> r0, r1;
        r0.Q = Q + rowb + (size_t)(y * QB) * DMODEL; r0.O = O + rowb + (size_t)(y * QB) * DMODEL; r0.K = K + rowb; r0.V = V + rowb; r0.P0 = y * QB;
        const int y1 = 7 - y;
        r1.Q = Q + rowb + (size_t)(y1 * QB) * DMODEL; r1.O = O + rowb + (size_t)(y1 * QB) * DMODEL; r1.K = K + rowb; r1.V = V + rowb; r1.P0 = y1 * QB;
        Seam<bf16> S;
        causal_swa_prime<bf16, bf16>(r0, 1 << 30, (char*)lds_g, S);
        causal_swa_block<bf16, bf16>(r0, r1, SEQ, 1 << 30, (char*)lds_g, S, nb);
        causal_swa_block<bf16, bf16>(r1, r1, SEQ, 1 << 30, (char*)lds_g, S, nb);
        asm volatile("s_waitcnt vmcnt(0) lgkmcnt(0)" ::: "memory"); __syncthreads();
    }
}

__device__ __forceinline__ void phase_final(const Params& P) {
    const int tid = threadIdx.x, lane = tid & 63, wave = tid >> 6; const int gw = blockIdx.x * NWAVES + wave, NGW = gridDim.x * NWAVES;
    const pg8::ss_t* ss = (const pg8::ss_t*)(P.ws + WS_SS) + 5 * M_TOK; const f32x4* g4 = (const f32x4*)P.in[I_FINN];
    const bf16_t* H = (const bf16_t*)(P.ws + WS_HB1);
    for (int r = gw; r < M_TOK; r += NGW) { const float rs = pg8::ss_rs(ss, r); const v4u* hr = (const v4u*)(H + (size_t)r * DMODEL) + lane; f32x4* o = (f32x4*)(P.out + (size_t)r * DMODEL) + 2 * lane;
#pragma unroll
        for (int j = 0; j < 4; ++j) { const v4u w = __builtin_nontemporal_load(hr + 64 * j); const f32x4 ga = g4[2 * lane + 128 * j], gb = g4[2 * lane + 128 * j + 1];
            const f32x4 a = (f32x4){__uint_as_float(w.x << 16), __uint_as_float(w.x & 0xffff0000u), __uint_as_float(w.y << 16), __uint_as_float(w.y & 0xffff0000u)};
            const f32x4 b = (f32x4){__uint_as_float(w.z << 16), __uint_as_float(w.z & 0xffff0000u), __uint_as_float(w.w << 16), __uint_as_float(w.w & 0xffff0000u)};
            __builtin_nontemporal_store(a * rs * ga, o + 128 * j); __builtin_nontemporal_store(b * rs * gb, o + 128 * j + 1); } }
}

#define RLX_AGENT __ATOMIC_RELAXED, __HIP_MEMORY_SCOPE_AGENT


#define XB_TMO      128
#define XB_XCNT(j)  (256  + 64 * (j))
#define XB_XSUB(j)  (1280 + 64 * (j))
#define XB_XGEN(j)  (2304 + 64 * (j))
#define XB_TOP      3328
#define XB_TOPGEN   3392
#define XCD_BAR_WORDS 3456
#define XB_SPIN_CAP (1u << 18)

__device__ __forceinline__ unsigned xb_ld(unsigned* p)              { return __hip_atomic_load(p, __ATOMIC_RELAXED, __HIP_MEMORY_SCOPE_AGENT); }
__device__ __forceinline__ unsigned xb_add(unsigned* p, unsigned v) { return __hip_atomic_fetch_add(p, v, __ATOMIC_RELAXED, __HIP_MEMORY_SCOPE_AGENT); }
__device__ __forceinline__ unsigned xb_xcc_id() { return (unsigned)__builtin_amdgcn_s_getreg((3 << 11) | 20) & 0xFu; }
#define XB_SPIN(cond, bar) do { unsigned _sp = 0; while (cond) { __builtin_amdgcn_s_sleep(1); \
    if ((++_sp & 255u) == 0u) { if (xb_ld(&(bar)[XB_TMO])) break; if (_sp > XB_SPIN_CAP) { atomicAdd(&(bar)[XB_TMO], 1u); break; } } } } while (0)

struct XcdBarrier {
    unsigned* bar; unsigned x;
    volatile LAS unsigned* st;
};

__device__ __forceinline__ XcdBarrier xcd_barrier_post(unsigned* bar, volatile LAS unsigned* st) {
    XcdBarrier b; b.bar = bar; b.x = xb_xcc_id(); b.st = st;
    if (threadIdx.x == 0) (void)xb_add(&bar[XB_XCNT(b.x)], 1u);
    return b;
}
__device__ __forceinline__ void xcd_barrier_complete(unsigned* bar, unsigned x, unsigned& nloc, unsigned& nx) {
    const unsigned G = gridDim.x * gridDim.y * gridDim.z;
    unsigned sum, cnt, mine, sp = 0u;
    for (;;) {
        sum = 0u; cnt = 0u; mine = 0u;
#pragma unroll
        for (unsigned j = 0; j < 16; ++j) { const unsigned c = xb_ld(&bar[XB_XCNT(j)]); sum += c; cnt += (c > 0u) ? 1u : 0u; mine = (j == x) ? c : mine; }
        if (sum == G) break;
        __builtin_amdgcn_s_sleep(1);
        if ((++sp & 255u) == 0u) { if (xb_ld(&bar[XB_TMO])) break; if (sp > XB_SPIN_CAP) { atomicAdd(&bar[XB_TMO], 1u); break; } }
    }
    nloc = mine > 0u ? mine : 1u; nx = cnt > 0u ? cnt : 1u;
}

__device__ __forceinline__ void xcd_barrier(const XcdBarrier& b) {
    asm volatile("s_waitcnt vmcnt(0)" ::: "memory");
    __syncthreads();
    if (threadIdx.x == 0) {
        unsigned* bar = b.bar;
        __builtin_amdgcn_s_waitcnt(0);
        unsigned nloc = b.st[0], nx = b.st[1];
        if (nloc == 0u) { xcd_barrier_complete(bar, b.x, nloc, nx); b.st[0] = nloc; b.st[1] = nx; }
        const unsigned old = xb_add(&bar[XB_XSUB(b.x)], 1u);
        const unsigned gen = old / nloc;
        if (old + 1u == (gen + 1u) * nloc) {
            __builtin_amdgcn_fence(__ATOMIC_RELEASE, "agent");
            asm volatile("s_waitcnt vmcnt(0)" ::: "memory");
            const unsigned og = xb_add(&bar[XB_TOP], 1u);
            const unsigned tg = og / nx;
            if (og + 1u == (tg + 1u) * nx) xb_add(&bar[XB_TOPGEN], 1u);
            else XB_SPIN(xb_ld(&bar[XB_TOPGEN]) == tg, bar);
            __builtin_amdgcn_fence(__ATOMIC_ACQUIRE, "agent");
            xb_add(&bar[XB_XGEN(b.x)], 1u);
            asm volatile("s_waitcnt vmcnt(0)" ::: "memory");
        } else {
            XB_SPIN(xb_ld(&bar[XB_XGEN(b.x)]) == gen, bar);
            __builtin_amdgcn_fence(__ATOMIC_ACQUIRE, "agent");
            asm volatile("s_waitcnt vmcnt(0)" ::: "memory");
        }
    }
    __syncthreads();
}

constexpr int NPHASES = 14;
__global__ void __launch_bounds__(NTHREADS, 2) fwd(Params P) {
    extern __shared__ __attribute__((aligned(16))) unsigned char lds_raw[];
    LAS unsigned char* lds = (LAS unsigned char*)lds_raw;
    unsigned char* ws = P.ws;
    const int lo = P.ph_lo, hi = P.ph_hi;
#define IN(k) (lo <= (k) && (k) < hi)
#define SEAM(k) do { if (IN(k) && IN((k) + 1)) { xcd_barrier(bar); } } while (0)
    XcdBarrier bar; bar.bar = (unsigned*)(ws + WS_BAR); bar.x = 0; bar.st = nullptr;
    if (P.coop) {
        if (blockIdx.x == 0) for (int i = threadIdx.x; i < XCD_BAR_WORDS; i += NTHREADS) ((unsigned*)(ws + WS_BAR))[i] = 0u;
        if (threadIdx.x < 2) ((volatile LAS unsigned*)(lds + LDS_MISC_OFF))[threadIdx.x] = 0u;
        __syncthreads();
        cg::this_grid().sync();
        bar = xcd_barrier_post((unsigned*)(ws + WS_BAR), (volatile LAS unsigned*)(lds + LDS_MISC_OFF)); }
    pg8::ss_t* SS = (pg8::ss_t*)(ws + WS_SS);
    bf16_t* HB0 = (bf16_t*)(ws + WS_HB0); bf16_t* HB1 = (bf16_t*)(ws + WS_HB1);
    bf16_t* PU = (bf16_t*)(ws + WS_PU); bf16_t* HID = (bf16_t*)(ws + WS_HID);
    const int G = gridDim.x, c = blockIdx.x;
    if (IN(0)) { phase_prologue(P, lds); asm volatile("s_waitcnt vmcnt(0) lgkmcnt(0)" ::: "memory"); __syncthreads(); }
    SEAM(0);
    if (IN(1)) {
        { pg8::Gemm g{(const bf16_t*)(ws + WS_XB), (const bf16_t*)(ws + WS_WIN), M_TOK, 8192, 2048}; pg8::StaticOrder S; S.init(M_TOK, 8192, G, c);
          pg8::EpiG1 E{(const float*)(ws + WS_RS0), (const float*)(ws + WS_LB), (bf16_t*)(ws + WS_QIN), (bf16_t*)(ws + WS_KIN), (float*)(ws + WS_DEC), (bf16_t*)(ws + WS_V0), (bf16_t*)(ws + WS_SG)};
          pg8::gemm_phase<pg8::EpiG1, pg8::StaticOrder, true, true>(lds, g, S, E); }
    }
    SEAM(1);
    if (IN(2)) { phase_scan(P, lds); }
    SEAM(2);
    if (IN(3)) {
        phase_weights1(P, lds);
        pg8::Gemm g{(const bf16_t*)P.out, (const bf16_t*)(ws + WS_WAOUT), M_TOK, 2048, 2048}; pg8::StaticOrder S; S.init(M_TOK, 2048, G, c);
        pg8::EpiRes<false> E{(const bf16_t*)(ws + WS_XB), HB0, SS + 0 * M_TOK};
        pg8::gemm_phase<pg8::EpiRes<false>, pg8::StaticOrder, true, true>(lds, g, S, E);
    }
    SEAM(3);
    if (IN(4)) {
        pg8::Gemm g{HB0, (const bf16_t*)(ws + WS_WUP0), M_TOK, 8192, 2048}; pg8::StaticOrder S; S.init(M_TOK, 8192, G, c);
        pg8::EpiUp E{HID, SS + 0 * M_TOK};
        pg8::gemm_phase<pg8::EpiUp, pg8::StaticOrder, true, true>(lds, g, S, E);
    }
    SEAM(4);
    if (IN(5)) {
        pg8::Gemm g{HID, (const bf16_t*)(ws + WS_WDN0), M_TOK, 2048, 8192}; pg8::StaticOrder S; S.init(M_TOK, 2048, G, c);
        pg8::EpiRes<false> E{HB0, HB1, SS + 1 * M_TOK};
        pg8::gemm_phase<pg8::EpiRes<false>, pg8::StaticOrder, true, true>(lds, g, S, E);
    }
    SEAM(5);
    if (IN(6)) {
        pg8::Gemm g{HB1, (const bf16_t*)(ws + WS_WG0), M_TOK, 2048, 2048}; pg8::StaticOrder S; S.init(M_TOK, 2048, G, c);
        pg8::EpiGate<false> E{HB1, nullptr, HB0, SS + 2 * M_TOK, SS + 1 * M_TOK, PU};
        pg8::gemm_phase<pg8::EpiGate<false>, pg8::StaticOrder, true, true>(lds, g, S, E);
    }
    SEAM(6);
    if (IN(7)) {
        pg8::Gemm g{HB0, (const bf16_t*)P.out + (size_t)M_TOK * DMODEL, M_TOK, 6144, 2048}; pg8::StaticOrder S; S.init(M_TOK, 6144, G, c);
        pg8::EpiStore E{(bf16_t*)(ws + WS_KB), (size_t)M_TOK * DMODEL, SS + 2 * M_TOK};
        pg8::gemm_phase<pg8::EpiStore, pg8::StaticOrder, true, true>(lds, g, S, E);
        phase_flogit(P, lds);
    }
    SEAM(7);
    if (IN(8)) { phase_attention(P, lds_raw); }
    SEAM(8);
    if (IN(9)) {
        pg8::Gemm g{(const bf16_t*)(ws + WS_AO), (const bf16_t*)P.out + (size_t)M_TOK * DMODEL + (size_t)6144 * 2048, M_TOK, 2048, 2048}; pg8::StaticOrder S; S.init(M_TOK, 2048, G, c);
        pg8::EpiRes<false> E{HB0, HB1, SS + 3 * M_TOK};
        pg8::gemm_phase<pg8::EpiRes<false>, pg8::StaticOrder, true, true>(lds, g, S, E);
    }
    SEAM(9);
    if (IN(10)) {
        pg8::Gemm g{HB1, (const bf16_t*)(ws + WS_WUP1), M_TOK, 8192, 2048}; pg8::StaticOrder S; S.init(M_TOK, 8192, G, c);
        pg8::EpiUp E{HID, SS + 3 * M_TOK};
        pg8::gemm_phase<pg8::EpiUp, pg8::StaticOrder, true, true>(lds, g, S, E);
    }
    SEAM(10);
    if (IN(11)) {
        pg8::Gemm g{HID, (const bf16_t*)(ws + WS_WDN1), M_TOK, 2048, 8192}; pg8::StaticOrder S; S.init(M_TOK, 2048, G, c);
        pg8::EpiRes<false> E{HB1, HB0, SS + 4 * M_TOK};
        pg8::gemm_phase<pg8::EpiRes<false>, pg8::StaticOrder, true, true>(lds, g, S, E);
    }
    SEAM(11);
    if (IN(12)) {
        pg8::Gemm g{HB0, (const bf16_t*)(ws + WS_WG1), M_TOK, 2048, 2048}; pg8::StaticOrder S; S.init(M_TOK, 2048, G, c);
        pg8::EpiGate<false> E{HB0, nullptr, HB1, SS + 5 * M_TOK, SS + 4 * M_TOK, PU + (size_t)M_TOK * DMODEL};
        pg8::gemm_phase<pg8::EpiGate<false>, pg8::StaticOrder, true, true>(lds, g, S, E);
    }
    SEAM(12);
    if (IN(13)) { phase_final(P); }
#undef IN
#undef SEAM
}

#ifndef MK_SINGLE
#define MK_SINGLE 1
#endif
extern "C" void kernel_launch(void* const* d_in, const int* in_sizes, int n_in, void* d_out, int out_size, void* d_ws, size_t ws_size, hipStream_t stream) {
    static int grid = 0;
    if (grid == 0) {
        if (n_in != 19 || out_size != M_TOK * DMODEL || ws_size < WS_END) { fprintf(stderr, "kernel_launch: unexpected shapes (n_in %d out %d ws %zu need %zu)\n", n_in, out_size, ws_size, (size_t)WS_END); grid = -1; return; }
        int dev = 0, cus = 0, per_cu = 0;
        (void)hipGetDevice(&dev); (void)hipDeviceGetAttribute(&cus, hipDeviceAttributeMultiprocessorCount, dev);
        if (hipFuncSetAttribute((const void*)fwd, hipFuncAttributeMaxDynamicSharedMemorySize, LDS_BYTES) != hipSuccess) { fprintf(stderr, "kernel_launch: hipFuncSetAttribute failed\n"); grid = -1; return; }
        if (hipOccupancyMaxActiveBlocksPerMultiprocessor(&per_cu, (const void*)fwd, NTHREADS, LDS_BYTES) != hipSuccess || per_cu < 1) { fprintf(stderr, "kernel_launch: occupancy query failed (%d)\n", per_cu); per_cu = 1; }
        (void)hipGetLastError();
        grid = cus * per_cu; if (grid <= 0) grid = 256;
    }
    if (grid < 0) return;
    Params p{};
    for (int i = 0; i < 19; ++i) p.in[i] = (const float*)d_in[i];
    p.out = (float*)d_out; p.ws = (unsigned char*)d_ws;
#if MK_SINGLE
    p.ph_lo = 0; p.ph_hi = NPHASES; p.coop = 1;
    void* args[] = {&p};
    hipError_t e = hipLaunchCooperativeKernel((const void*)fwd, dim3(grid), dim3(NTHREADS), args, LDS_BYTES, stream);
    if (e != hipSuccess) fprintf(stderr, "cooperative launch failed: %s (grid %d)\n", hipGetErrorString(e), grid);
#else
    for (int ph = 0; ph < NPHASES; ++ph) { p.ph_lo = ph; p.ph_hi = ph + 1; p.coop = 0;
        hipLaunchKernelGGL(fwd, dim3(grid), dim3(NTHREADS), LDS_BYTES, stream, p); }
#endif
}
```

```cpp
#include <hip/hip_runtime.h>
#include <hip/hip_bf16.h>
#include <hip/hip_cooperative_groups.h>
#include <cstdio>
#include <cstdint>
namespace cg = cooperative_groups;
namespace pg8 {
#define PG8_LAS __attribute__((address_space(3)))
typedef unsigned short bf16_t;
typedef short bf16x8 __attribute__((ext_vector_type(8)));
typedef float f32x4 __attribute__((ext_vector_type(4)));
typedef unsigned u32x4 __attribute__((ext_vector_type(4)));
constexpr int BM = 256, BK = 64, HALF = 128, HTB = HALF * BK * 2  , STAGE_BYTES = 8 * HTB, NXCD = 8, WGM = 8;

__host__ __device__ __forceinline__ int lds_byte(int r, int c) { const int st = (r >> 4) * 2 + (c >> 5), rr = r & 15, cc = c & 31, ob = rr * 64 + cc * 2; return st * 1024 + (ob ^ (((ob >> 9) & 1) << 5)); }
__host__ __device__ __forceinline__ void stage_rc(int b, int& R, int& C) { const int st = b / 1024, sb = b % 1024, swz = sb ^ (((sb >> 9) & 1) << 5); R = (st >> 1) * 16 + swz / 64; C = (st & 1) * 32 + (swz % 64) / 2; }
__host__ __device__ __forceinline__ int perm32(int rho) { const int n = rho >> 4, i = rho & 15; return 8 * (i >> 2) + 4 * n + (i & 3); }

struct Unit { int pm, pn; };
struct Gemm { const bf16_t* A; const bf16_t* Bt; int M, N, K; };

struct StaticOrder {
    int nM, nN, nwg, G, c;
    __host__ __device__ void init(int M, int N, int G_, int c_) { nM = M / BM; nN = N / BM; nwg = nM * nN; G = G_; c = c_; }
    __host__ __device__ bool next(int i, Unit& u) const {
        const long L = (long)i * G + c; if (L >= nwg) return false;
        int wgid = (int)L; { const int q = nwg / NXCD, r = nwg % NXCD, xcd = wgid % NXCD, off = wgid / NXCD; wgid = (xcd < r ? xcd * (q + 1) : r * (q + 1) + (xcd - r) * q) + off; }
        const int nig = WGM * nN, gid = wgid / nig, fm = gid * WGM, gsz = (nM - fm) < WGM ? (nM - fm) : WGM;
        u.pm = fm + ((wgid % nig) % gsz); u.pn = (wgid % nig) / gsz; return true;
    }
    __device__ __forceinline__ void a_ready(const Unit&) const {}
    __device__ __forceinline__ void done(const Unit&) const {}
};

__device__ __forceinline__ unsigned cvt_pk_bf16(float lo, float hi) { unsigned r; asm volatile("v_cvt_pk_bf16_f32 %0, %1, %2" : "=v"(r) : "v"(lo), "v"(hi)); return r; }
typedef float f32x2 __attribute__((ext_vector_type(2)));
typedef unsigned u32x2 __attribute__((ext_vector_type(2)));
__device__ __forceinline__ float sigmoidf_(float x) { return __builtin_amdgcn_rcpf(1.0f + __expf(-x)); }
__device__ __forceinline__ u32x2 pack4(f32x4 v) { u32x2 w; w.x = cvt_pk_bf16(v[0], v[1]); w.y = cvt_pk_bf16(v[2], v[3]); return w; }
__device__ __forceinline__ float bf_lo(unsigned w) { return __uint_as_float(w << 16); }
__device__ __forceinline__ float bf_hi(unsigned w) { return __uint_as_float(w & 0xffff0000u); }
constexpr float RMS_EPS = 1e-6f;
typedef long long ss_t;
constexpr float SS_SCALE = 1048576.0f;
__device__ __forceinline__ float ss_rs(const ss_t* ss, int row) { return rsqrtf((float)ss[row] * (1.0f / (1048576.0f * 2048.0f)) + RMS_EPS); }
__device__ __forceinline__ void ss_add(ss_t* ss, int row, float s) { __hip_atomic_fetch_add(ss + row, (ss_t)(s * SS_SCALE), __ATOMIC_RELAXED, __HIP_MEMORY_SCOPE_AGENT); }
constexpr int LDM = 2048;

typedef unsigned u32x4e __attribute__((ext_vector_type(4)));
__device__ __forceinline__ u32x4e pack8(f32x4 a, f32x4 b) { u32x4e w; w.x = cvt_pk_bf16(a[0], a[1]); w.y = cvt_pk_bf16(a[2], a[3]); w.z = cvt_pk_bf16(b[0], b[1]); w.w = cvt_pk_bf16(b[2], b[3]); return w; }
__device__ __forceinline__ void unpack8(u32x4e w, f32x4& a, f32x4& b) { a = (f32x4){bf_lo(w.x), bf_hi(w.x), bf_lo(w.y), bf_hi(w.y)}; b = (f32x4){bf_lo(w.z), bf_hi(w.z), bf_lo(w.w), bf_hi(w.w)}; }
template <int CTRL> __device__ __forceinline__ float dpp_shr0(float x) { return __builtin_bit_cast(float, __builtin_amdgcn_update_dpp(0, __builtin_bit_cast(int, x), CTRL, 0xf, 0xf, false)); }
struct EpiG1 {
    static constexpr bool PERM = true, AFTER_DRAIN = false;
    const float* rs; const float* lb; bf16_t* QIN; bf16_t* KIN; float* DEC; bf16_t* V0; bf16_t* SG;
    __device__ __forceinline__ void operator()(const f32x4 (&acc)[2][2][4][2], const Unit& u, int wr, int wc, int fr, int fq) const {
        const int type = ((u.pn >> 2) ^ u.pn) & 1; const int col = (u.pn >> 1) * 128 + wc * 32 + fq * 8;
#pragma unroll
        for (int ai = 0; ai < 2; ++ai)
#pragma unroll
            for (int m = 0; m < 4; ++m) { const int row = u.pm * BM + ai * HALF + wr * 64 + m * 16 + fr; const float r = rs[row]; const size_t off = (size_t)row * LDM + col;
                if (type == 1) { f32x4 o[2];
#pragma unroll
                    for (int n = 0; n < 2; ++n)
#pragma unroll
                        for (int i = 0; i < 4; ++i) { const float g = acc[ai][1][m][n][i] * r; o[n][i] = g * sigmoidf_(g); }
                    *(u32x4e*)(V0 + off) = pack8(acc[ai][0][m][0] * r, acc[ai][0][m][1] * r); *(u32x4e*)(SG + off) = pack8(o[0], o[1]); }
                else { f32x4 qi[2], ki[2], de[2];
#pragma unroll
                    for (int n = 0; n < 2; ++n) { const f32x4 l = *(const f32x4*)(lb + col + 4 * n);
#pragma unroll
                        for (int i = 0; i < 4; ++i) { const float qv = acc[ai][0][m][n][i] * r, fv = acc[ai][1][m][n][i] * r;
                            const float fg = l[i] + (1.0f - l[i]) * sigmoidf_(fv); float b = __logf(fg);
                            b += dpp_shr0<0x111>(b); b += dpp_shr0<0x112>(b); b += dpp_shr0<0x114>(b); b += dpp_shr0<0x118>(b);
                            const float eb = __expf(b), kk = 1.0f - fg, ebi = __builtin_amdgcn_rcpf(eb);
                            qi[n][i] = qv * sigmoidf_(qv) * 0.08838834764831845f * eb; ki[n][i] = kk * ebi; de[n][i] = eb; } }
                    *(u32x4e*)(QIN + off) = pack8(qi[0], qi[1]); *(u32x4e*)(KIN + off) = pack8(ki[0], ki[1]);
                    if (fr == 15) { float* d = DEC + (size_t)(row >> 4) * LDM + col; *(f32x4*)d = de[0]; *(f32x4*)(d + 4) = de[1]; } } }
    }
};
struct EpiStore {
    static constexpr bool PERM = true, AFTER_DRAIN = false;
    bf16_t* dst; size_t rstride; const ss_t* ss;
    __device__ __forceinline__ void operator()(const f32x4 (&acc)[2][2][4][2], const Unit& u, int wr, int wc, int fr, int fq) const {
        bf16_t* d = dst + (size_t)(u.pn >> 3) * rstride; const int cb = (u.pn & 7) * 256 + wc * 32 + fq * 8;
#pragma unroll
        for (int ai = 0; ai < 2; ++ai)
#pragma unroll
            for (int m = 0; m < 4; ++m) { const int row = u.pm * BM + ai * HALF + wr * 64 + m * 16 + fr; const float r = ss ? ss_rs(ss, row) : 1.0f;
#pragma unroll
                for (int bj = 0; bj < 2; ++bj) { const size_t off = (size_t)row * LDM + cb + bj * HALF; *(u32x4e*)(d + off) = pack8(acc[ai][bj][m][0] * r, acc[ai][bj][m][1] * r); } }
    }
};
struct EpiUp {
    static constexpr bool PERM = true, AFTER_DRAIN = false;
    bf16_t* dst; const ss_t* ss;
    __device__ __forceinline__ void operator()(const f32x4 (&acc)[2][2][4][2], const Unit& u, int wr, int wc, int fr, int fq) const {
        const int cb = u.pn * 256 + wc * 32 + fq * 8;
#pragma unroll
        for (int ai = 0; ai < 2; ++ai)
#pragma unroll
            for (int m = 0; m < 4; ++m) { const int row = u.pm * BM + ai * HALF + wr * 64 + m * 16 + fr; const float r = ss_rs(ss, row);
#pragma unroll
                for (int bj = 0; bj < 2; ++bj) { const size_t off = (size_t)row * 8192 + cb + bj * HALF; f32x4 v[2];
#pragma unroll
                    for (int n = 0; n < 2; ++n)
#pragma unroll
                        for (int i = 0; i < 4; ++i) { const float t = fmaxf(acc[ai][bj][m][n][i] * r, 0.f); v[n][i] = t * t; }
                    *(u32x4e*)(dst + off) = pack8(v[0], v[1]); } }
    }
};
template <bool BASE_F32> struct EpiRes {
    static constexpr bool PERM = true, AFTER_DRAIN = false;
    const void* base; bf16_t* outb; ss_t* ssout;
    __device__ __forceinline__ void operator()(const f32x4 (&acc)[2][2][4][2], const Unit& u, int wr, int wc, int fr, int fq) const {
        const int cb = u.pn * 256 + wc * 32 + fq * 8;
#pragma unroll
        for (int ai = 0; ai < 2; ++ai)
#pragma unroll
            for (int m = 0; m < 4; ++m) { const int row = u.pm * BM + ai * HALF + wr * 64 + m * 16 + fr; float s = 0.f;
#pragma unroll
                for (int bj = 0; bj < 2; ++bj) { const size_t off = (size_t)row * LDM + cb + bj * HALF; f32x4 h0, h1;
                    if (BASE_F32) { h0 = __builtin_nontemporal_load((const f32x4*)((const float*)base + off)); h1 = __builtin_nontemporal_load((const f32x4*)((const float*)base + off + 4)); }
                    else unpack8(__builtin_nontemporal_load((const u32x4e*)((const bf16_t*)base + off)), h0, h1);
                    h0 = h0 + acc[ai][bj][m][0]; h1 = h1 + acc[ai][bj][m][1];
                    *(u32x4e*)(outb + off) = pack8(h0, h1);
                    s += ((h0[0] * h0[0] + h0[1] * h0[1]) + (h0[2] * h0[2] + h0[3] * h0[3])) + ((h1[0] * h1[0] + h1[1] * h1[1]) + (h1[2] * h1[2] + h1[3] * h1[3])); }
                s += __shfl_xor(s, 16); s += __shfl_xor(s, 32);
                if (fq == 0) ss_add(ssout, row, s); }
    }
};
template <bool OUT_F32> struct EpiGate {
    static constexpr bool PERM = true, AFTER_DRAIN = false;
    const bf16_t* base; float* outf; bf16_t* outb; ss_t* ssout; const ss_t* ss; const bf16_t* pu;
    __device__ __forceinline__ void operator()(const f32x4 (&acc)[2][2][4][2], const Unit& u, int wr, int wc, int fr, int fq) const {
        const int cb = u.pn * 256 + wc * 32 + fq * 8;
#pragma unroll
        for (int ai = 0; ai < 2; ++ai)
#pragma unroll
            for (int m = 0; m < 4; ++m) { const int row = u.pm * BM + ai * HALF + wr * 64 + m * 16 + fr; float s = 0.f; const float r = ss_rs(ss, row);
#pragma unroll
                for (int bj = 0; bj < 2; ++bj) { const size_t off = (size_t)row * LDM + cb + bj * HALF; f32x4 h[2], p[2];
                    unpack8(__builtin_nontemporal_load((const u32x4e*)(base + off)), h[0], h[1]); unpack8(__builtin_nontemporal_load((const u32x4e*)(pu + off)), p[0], p[1]);
#pragma unroll
                    for (int n = 0; n < 2; ++n)
#pragma unroll
                        for (int i = 0; i < 4; ++i) { h[n][i] += p[n][i] * sigmoidf_(acc[ai][bj][m][n][i] * r); s += h[n][i] * h[n][i]; }
                    if (OUT_F32) { *(f32x4*)(outf + off) = h[0]; *(f32x4*)(outf + off + 4) = h[1]; } else *(u32x4e*)(outb + off) = pack8(h[0], h[1]); }
                s += __shfl_xor(s, 16); s += __shfl_xor(s, 32);
                if (fq == 0) ss_add(ssout, row, s); }
    }
};
template <class Epi, class Sched, bool ALIGN_EPI = false, bool SP2 = false>
__device__ __forceinline__ void gemm_phase(PG8_LAS unsigned char* lds, const Gemm g, const Sched& S, const Epi& E) {
    const int tid = threadIdx.x, wid = __builtin_amdgcn_readfirstlane(tid >> 6), lane = tid & 63, wr = wid >> 2, wc = wid & 3, fr = lane & 15, fq = lane >> 4;
    const int K = g.K, nt = K / BK;
    unsigned voffA[2], voffB[2];
#pragma unroll
    for (int i = 0; i < 2; ++i) { int R, C; stage_rc(tid * 16 + i * 8192, R, C); const int Rb = Epi::PERM ? ((R & ~31) + perm32(R & 31)) : R;
        voffA[i] = (unsigned)(R * K + C) * 2u; voffB[i] = (unsigned)(Rb * K + C) * 2u; }
    const size_t kstep = (size_t)(BK * 2);
    const size_t hstep = (size_t)HALF * K * 2;
    const size_t tstep = 2 * hstep;
    const unsigned ldsw = (unsigned)wid * 1024u;
    const int aoff = lds_byte(wr * 64 + fr, fq * 8), boff = lds_byte(wc * 32 + fr, fq * 8);
#define PG8_SA(b, h) (((b) * 2 + (h)) * HTB)
#define PG8_SB(b, h) ((4 + (b) * 2 + (h)) * HTB)
#define PG8_STAGE(bufoff, gbase, voff) do { _Pragma("unroll") for (int _i = 0; _i < 2; ++_i) \
        __builtin_amdgcn_global_load_lds((const unsigned*)((const char*)(gbase) + (voff)[_i]), (PG8_LAS unsigned*)(lds + (bufoff) + ldsw + _i * 8192), 16, 0, 0); } while (0)
#define PG8_LDA(dst, b, h) do { _Pragma("unroll") for (int m = 0; m < 4; ++m) _Pragma("unroll") for (int k = 0; k < 2; ++k) dst[m][k] = *(const PG8_LAS bf16x8*)(lds + PG8_SA(b, h) + aoff + m * 2048 + k * 1024); } while (0)
#define PG8_LDB(dst, b, h) do { _Pragma("unroll") for (int n = 0; n < 2; ++n) _Pragma("unroll") for (int k = 0; k < 2; ++k) dst[n][k] = *(const PG8_LAS bf16x8*)(lds + PG8_SB(b, h) + boff + n * 2048 + k * 1024); } while (0)
#define PG8_MMA(ai, bj, At, Bt) do { __builtin_amdgcn_s_setprio(1); _Pragma("unroll") for (int m = 0; m < 4; ++m) _Pragma("unroll") for (int n = 0; n < 2; ++n) _Pragma("unroll") for (int k = 0; k < 2; ++k) \
        acc[ai][bj][m][n] = __builtin_amdgcn_mfma_f32_16x16x32_bf16(Bt[n][k], At[m][k], acc[ai][bj][m][n], 0, 0, 0); __builtin_amdgcn_s_setprio(0); } while (0)
#define PG8_WAIT_V(n) asm volatile("s_waitcnt vmcnt(" #n ")" ::: "memory")
#define PG8_WAIT_L(n) asm volatile("s_waitcnt lgkmcnt(" #n ")" ::: "memory")
#define PG8_BAR __builtin_amdgcn_s_barrier()
#define PG8_SCHED __builtin_amdgcn_sched_barrier(0)
    Unit cur, nxt; int ui = 0;
    if (!S.next(0, cur)) return;
    f32x4 acc[2][2][4][2];
#pragma unroll
    for (int a = 0; a < 2; ++a)
#pragma unroll
        for (int b = 0; b < 2; ++b)
#pragma unroll
            for (int m = 0; m < 4; ++m)
#pragma unroll
                for (int n = 0; n < 2; ++n) acc[a][b][m][n] = (f32x4){0.f, 0.f, 0.f, 0.f};
    bf16x8 At[4][2], B0[2][2], B1[2][2];
    const char* cA = (const char*)g.A + (size_t)cur.pm * tstep; const char* cB = (const char*)g.Bt + (size_t)cur.pn * tstep;
    S.a_ready(cur);
    if constexpr (SP2) {
        PG8_STAGE(PG8_SB(0, 0), cB, voffB); PG8_STAGE(PG8_SB(0, 1), cB + hstep, voffB); PG8_STAGE(PG8_SA(0, 0), cA, voffA); PG8_STAGE(PG8_SA(0, 1), cA + hstep, voffA);
        if (wr == 1) PG8_BAR;
        PG8_WAIT_V(2); PG8_BAR;
        PG8_STAGE(PG8_SB(1, 0), cB + kstep, voffB); PG8_STAGE(PG8_SA(1, 0), cA + kstep, voffA); PG8_STAGE(PG8_SB(1, 1), cB + hstep + kstep, voffB);
        PG8_WAIT_V(6); PG8_BAR;
    } else {
        PG8_STAGE(PG8_SB(0, 0), cB, voffB); PG8_STAGE(PG8_SA(0, 0), cA, voffA); PG8_STAGE(PG8_SB(0, 1), cB + hstep, voffB); PG8_STAGE(PG8_SA(0, 1), cA + hstep, voffA);
        if (wr == 1) PG8_BAR;
        PG8_WAIT_V(4); PG8_BAR;
        PG8_STAGE(PG8_SB(1, 0), cB + kstep, voffB); PG8_STAGE(PG8_SA(1, 0), cA + kstep, voffA); PG8_STAGE(PG8_SB(1, 1), cB + hstep + kstep, voffB);
        PG8_WAIT_V(6); PG8_BAR;
    }
    for (;;) {
        const bool has_next = S.next(ui + 1, nxt);
        const char* nA = has_next ? (const char*)g.A + (size_t)nxt.pm * tstep : cA; const char* nB = has_next ? (const char*)g.Bt + (size_t)nxt.pn * tstep : cB;
        for (int t = 0; t < nt; t += 2) {
            const bool last = (t == nt - 2);
            const char* a1 = cA + (size_t)(t + 1) * kstep;
            const char* a2 = last ? nA : cA + (size_t)(t + 2) * kstep; const char* b2 = last ? nB : cB + (size_t)(t + 2) * kstep;
            const char* a3 = a2 + kstep; const char* b3 = b2 + kstep;
            if (last && has_next) S.a_ready(nxt);
            if constexpr (SP2) {
            PG8_LDB(B0, 0, 0); PG8_LDB(B1, 0, 1); PG8_SCHED; PG8_LDA(At, 0, 0); PG8_STAGE(PG8_SA(1, 1), a1 + hstep, voffA);
            PG8_WAIT_V(8); PG8_WAIT_L(0); PG8_BAR; PG8_MMA(0, 0, At, B0); PG8_MMA(0, 1, At, B1); PG8_BAR; PG8_SCHED;
            PG8_LDA(At, 0, 1); PG8_STAGE(PG8_SB(0, 0), b2, voffB); PG8_STAGE(PG8_SB(0, 1), b2 + hstep, voffB); PG8_STAGE(PG8_SA(0, 0), a2, voffA);
            PG8_WAIT_V(8); PG8_WAIT_L(0); PG8_BAR; PG8_MMA(1, 0, At, B0); PG8_MMA(1, 1, At, B1); PG8_BAR; PG8_SCHED;
            PG8_LDB(B0, 1, 0); PG8_LDB(B1, 1, 1); PG8_SCHED; PG8_LDA(At, 1, 0); PG8_STAGE(PG8_SA(0, 1), a2 + hstep, voffA);
            PG8_WAIT_V(8); PG8_WAIT_L(0); PG8_BAR; PG8_MMA(0, 0, At, B0); PG8_MMA(0, 1, At, B1); PG8_BAR; PG8_SCHED;
            PG8_LDA(At, 1, 1); PG8_STAGE(PG8_SB(1, 0), b3, voffB); PG8_STAGE(PG8_SB(1, 1), b3 + hstep, voffB); PG8_STAGE(PG8_SA(1, 0), a3, voffA);
            PG8_WAIT_V(8); PG8_WAIT_L(0); PG8_BAR; PG8_MMA(1, 0, At, B0); PG8_MMA(1, 1, At, B1); PG8_BAR; PG8_SCHED;
            } else {
            PG8_LDB(B0, 0, 0); PG8_SCHED; PG8_LDA(At, 0, 0); PG8_STAGE(PG8_SA(1, 1), a1 + hstep, voffA);
            PG8_WAIT_L(8); PG8_BAR; PG8_WAIT_L(0); PG8_MMA(0, 0, At, B0); PG8_BAR; PG8_SCHED;
            PG8_LDB(B1, 0, 1); PG8_STAGE(PG8_SB(0, 0), b2, voffB);
            PG8_BAR; PG8_WAIT_L(0); PG8_MMA(0, 1, At, B1); PG8_BAR;
            PG8_LDA(At, 0, 1); PG8_STAGE(PG8_SA(0, 0), a2, voffA);
            PG8_BAR; PG8_WAIT_L(0); PG8_MMA(1, 0, At, B0); PG8_BAR; PG8_SCHED;
            PG8_STAGE(PG8_SB(0, 1), b2 + hstep, voffB);
            PG8_WAIT_V(6); PG8_BAR; PG8_MMA(1, 1, At, B1); PG8_BAR;
            PG8_LDB(B0, 1, 0); PG8_SCHED; PG8_LDA(At, 1, 0); PG8_STAGE(PG8_SA(0, 1), a2 + hstep, voffA);
            PG8_WAIT_L(8); PG8_BAR; PG8_WAIT_L(0); PG8_MMA(0, 0, At, B0); PG8_BAR; PG8_SCHED;
            PG8_LDB(B1, 1, 1); PG8_STAGE(PG8_SB(1, 0), b3, voffB);
            PG8_BAR; PG8_WAIT_L(0); PG8_MMA(0, 1, At, B1); PG8_BAR;
            PG8_LDA(At, 1, 1); PG8_STAGE(PG8_SA(1, 0), a3, voffA);
            PG8_BAR; PG8_WAIT_L(0); PG8_MMA(1, 0, At, B0); PG8_BAR; PG8_SCHED;
            PG8_STAGE(PG8_SB(1, 1), b3 + hstep, voffB);
            PG8_WAIT_V(6); PG8_BAR; PG8_MMA(1, 1, At, B1); PG8_BAR;
            }
        }
        if constexpr (ALIGN_EPI) { if (wr == 0) PG8_BAR; }
        if constexpr (!Epi::AFTER_DRAIN) { E(acc, cur, wr, wc, fr, fq); S.done(cur); }
        if (!has_next) break;
#pragma unroll
        for (int a = 0; a < 2; ++a)
#pragma unroll
            for (int b = 0; b < 2; ++b)
#pragma unroll
                for (int m = 0; m < 4; ++m)
#pragma unroll
                    for (int n = 0; n < 2; ++n) acc[a][b][m][n] = (f32x4){0.f, 0.f, 0.f, 0.f};
        cur = nxt; cA = nA; cB = nB; ++ui;
        if constexpr (ALIGN_EPI) { if (wr == 1) PG8_BAR; }
    }
    PG8_WAIT_V(0);
    if constexpr (!ALIGN_EPI) { if (wr == 0) PG8_BAR; }
    PG8_BAR;
    if constexpr (Epi::AFTER_DRAIN) { E.fused(acc, cur, wr, wc, fr, fq, lds, wid, lane); S.done(cur); }
#undef PG8_SA
#undef PG8_SB
#undef PG8_STAGE
#undef PG8_LDA
#undef PG8_LDB
#undef PG8_MMA
#undef PG8_WAIT_V
#undef PG8_WAIT_L
#undef PG8_BAR
#undef PG8_SCHED
}
}
namespace attn {
constexpr int D = 128, LDR = 2048, QLDS_OFF = 78080; constexpr float THR = 24.f;   constexpr bool WSKIP = false;
constexpr float SCALE = 0.08838834764831845f;
constexpr int NW = 8, QBLK = 32, KVBLK = 64, QB = NW * QBLK;
constexpr int SHM_V = KVBLK * D * 2, SHM_K = KVBLK * D * 2;
constexpr int LDS_BYTES = 2 * SHM_V + 2 * SHM_K + NW * 64 * 4;


using bf16 = __hip_bfloat16;
typedef short bf16x8 __attribute__((ext_vector_type(8)));
typedef short s16x4 __attribute__((ext_vector_type(4)));
typedef float f32x16 __attribute__((ext_vector_type(16)));
typedef float f32x4 __attribute__((ext_vector_type(4)));
typedef unsigned u32x4 __attribute__((ext_vector_type(4)));
template <class A, class Bt> struct same_t { static constexpr bool v = false; };
template <class A> struct same_t<A, A> { static constexpr bool v = true; };

#define KSWZ(row, colB) ((row) * 256 + ((colB) ^ (((row) & 7) << 4)))
#define SBAR() __builtin_amdgcn_sched_barrier(0)
__device__ __forceinline__ int v_st(int k, int c) { const int kk = (k & ~0xC) | ((k & 4) << 1) | ((k & 8) >> 1); return ((kk >> 3) * 4 + (c >> 5)) * 512 + ((kk & 7) * 32 + (c & 31)) * 2; }
__device__ __forceinline__ int v_rd_base(int lane) { return ((lane & 3) << 3) | (((lane >> 2) & 3) << 6) | (((lane >> 4) & 1) << 5) | (((lane >> 5) & 1) << 8); }
constexpr int v_rd_off(int d0, int ks, int half) { return d0 * 512 + ks * 4096 + half * 2048; }
__device__ __forceinline__ int crow(int r, int hi) { return (r & 3) + 8 * (r >> 2) + 4 * hi; }
__device__ __forceinline__ unsigned cvtpk(float lo, float hi) {
    unsigned r; asm volatile("v_cvt_pk_bf16_f32 %0, %1, %2" : "=v"(r) : "v"(lo), "v"(hi)); return r;
}
__device__ __forceinline__ bf16x8 pack8(f32x4 a, f32x4 b) {
    u32x4 w = {cvtpk(a[0], a[1]), cvtpk(a[2], a[3]), cvtpk(b[0], b[1]), cvtpk(b[2], b[3])};
    return *reinterpret_cast<bf16x8*>(&w);
}
template <class T> __device__ __forceinline__ bf16x8 load8(const T* p) {
    if constexpr (same_t<T, float>::v) { return pack8(*(const f32x4*)p, *(const f32x4*)(p + 4)); }
    else { return *reinterpret_cast<const bf16x8*>(p); }
}
__device__ __forceinline__ void mask_tile(f32x16& p0, f32x16& p1, int dq, unsigned W) {
    const float NEG = -__builtin_inff();
#pragma unroll
    for (int r = 0; r < 16; ++r) {
        const int c = (r & 3) + 8 * (r >> 2);
        if ((unsigned)(dq - c) >= W) p0[r] = NEG;
        if ((unsigned)(dq - c - 32) >= W) p1[r] = NEG;
    }
}
__device__ __forceinline__ void partialSM(f32x16& p0, f32x16& p1, float& m_reg, float& mn, float& alpha, float mfloor) {
    float pmax = p0[0]; for (int r = 1; r < 16; ++r) pmax = fmaxf(pmax, p0[r]); for (int r = 0; r < 16; ++r) pmax = fmaxf(pmax, p1[r]);
    { auto rr = __builtin_amdgcn_permlane32_swap(__float_as_uint(pmax), __float_as_uint(pmax), false, false);
      pmax = fmaxf(__uint_as_float(rr[0]), __uint_as_float(rr[1])); }
    constexpr float C2 = 1.4426950408889634f * SCALE;
    if (__builtin_expect(__all((pmax - m_reg) * SCALE <= THR), 1)) { mn = m_reg; alpha = 1.f; }
    else { mn = fmaxf(fmaxf(m_reg, pmax), mfloor); alpha = __builtin_amdgcn_exp2f((m_reg - mn) * C2); m_reg = mn; }
    const float mnL = -mn * C2;
    for (int r = 0; r < 16; ++r) p0[r] = fmaf(p0[r], C2, mnL); for (int r = 0; r < 16; ++r) p1[r] = fmaf(p1[r], C2, mnL);
    for (int r = 0; r < 16; ++r) p0[r] = __builtin_amdgcn_exp2f(p0[r]);
}
__device__ __forceinline__ void finishSM(f32x16& p0, f32x16& p1, float alpha, float& l_reg, bf16x8& pa0, bf16x8& pa1, bf16x8& pa2, bf16x8& pa3) {
    for (int r = 0; r < 16; ++r) p1[r] = __builtin_amdgcn_exp2f(p1[r]);
    float ps = 0; for (int r = 0; r < 16; ++r) ps += p0[r]; for (int r = 0; r < 16; ++r) ps += p1[r];
    { auto rr = __builtin_amdgcn_permlane32_swap(__float_as_uint(ps), __float_as_uint(ps), false, false);
      ps = __uint_as_float(rr[0]) + __uint_as_float(rr[1]); }
    l_reg = l_reg * alpha + ps;
#define PK4(P, B_, OUT) do { unsigned a0 = cvtpk(P[B_+0], P[B_+1]), a1 = cvtpk(P[B_+2], P[B_+3]);                          \
        unsigned b0 = cvtpk(P[B_+4], P[B_+5]), b1 = cvtpk(P[B_+6], P[B_+7]);                                             \
        auto r0 = __builtin_amdgcn_permlane32_swap(a0, b0, false, false); auto r1 = __builtin_amdgcn_permlane32_swap(a1, b1, false, false); \
        u32x4 w = {r0[0], r1[0], r0[1], r1[1]}; OUT = *reinterpret_cast<bf16x8*>(&w); } while (0)
    PK4(p0, 0, pa0); PK4(p0, 8, pa1); PK4(p1, 0, pa2); PK4(p1, 8, pa3);
#undef PK4
}
template <int KB, bool SK>
__device__ __forceinline__ void qkt(f32x16& p0, f32x16& p1, const char* K_lds, int r32, int hi, const char* qlds, bool act, const float* nbp) {
    if (SK && !act) { const float NEG = -__builtin_inff();
#pragma unroll
        for (int r = 0; r < 16; ++r) { p0[r] = NEG; p1[r] = NEG; } return; }
    { _Pragma("unroll") for (int j_ = 0; j_ < 4; ++j_) { const f32x4 b0_ = *(const f32x4*)(nbp + 8 * j_), b1_ = *(const f32x4*)(nbp + 32 + 8 * j_);
        _Pragma("unroll") for (int i_ = 0; i_ < 4; ++i_) { p0[4 * j_ + i_] = b0_[i_]; p1[4 * j_ + i_] = b1_[i_]; } } }
    const char* kb[4];
#pragma unroll
    for (int dd = 0; dd < 4; ++dd) kb[dd] = K_lds + KB * SHM_K + KSWZ(r32, (dd * 16 + hi * 8) * 2);
#pragma unroll
    for (int d0 = 0; d0 < 8; ++d0) { const char* a = kb[d0 & 3] + (d0 >> 2) * 128;
        bf16x8 b0 = *reinterpret_cast<const bf16x8*>(a);
        bf16x8 b1 = *reinterpret_cast<const bf16x8*>(a + 32 * 256);
        const bf16x8 qf = *reinterpret_cast<const bf16x8*>(qlds + d0 * 1024);
        p0 = __builtin_amdgcn_mfma_f32_32x32x16_bf16(b0, qf, p0, 0, 0, 0);
        p1 = __builtin_amdgcn_mfma_f32_32x32x16_bf16(b1, qf, p1, 0, 0, 0); }
}
template <int VB, bool SK>
__device__ __forceinline__ void pv_tile(f32x16* o, int vb0, bf16x8 pa0, bf16x8 pa1, bf16x8 pa2, bf16x8 pa3, bool act) {
    if (SK && !act) return;
#define TRRD(dst, off) asm volatile("ds_read_b64_tr_b16 %0, %1 offset:%2" : "=&v"(dst) : "v"(vb0), "i"(off) : "memory")
#define PV_D0(d0) do { s16x4 l0, l1, l2, l3, h0, h1, h2, h3; constexpr int b_ = VB * SHM_V + v_rd_off(d0, 0, 0);     \
        TRRD(l0, b_); TRRD(h0, b_ + 2048); TRRD(l1, b_ + 4096); TRRD(h1, b_ + 6144); TRRD(l2, b_ + 8192); TRRD(h2, b_ + 10240); TRRD(l3, b_ + 12288); TRRD(h3, b_ + 14336); \
        asm volatile("s_waitcnt lgkmcnt(0)" ::: "memory"); SBAR();                 \
        o[d0] = __builtin_amdgcn_mfma_f32_32x32x16_bf16(pa0, (bf16x8){l0[0], l0[1], l0[2], l0[3], h0[0], h0[1], h0[2], h0[3]}, o[d0], 0, 0, 0);   \
        o[d0] = __builtin_amdgcn_mfma_f32_32x32x16_bf16(pa1, (bf16x8){l1[0], l1[1], l1[2], l1[3], h1[0], h1[1], h1[2], h1[3]}, o[d0], 0, 0, 0);   \
        o[d0] = __builtin_amdgcn_mfma_f32_32x32x16_bf16(pa2, (bf16x8){l2[0], l2[1], l2[2], l2[3], h2[0], h2[1], h2[2], h2[3]}, o[d0], 0, 0, 0);   \
        o[d0] = __builtin_amdgcn_mfma_f32_32x32x16_bf16(pa3, (bf16x8){l3[0], l3[1], l3[2], l3[3], h3[0], h3[1], h3[2], h3[3]}, o[d0], 0, 0, 0); } while (0)
    PV_D0(0); PV_D0(1); PV_D0(2); PV_D0(3);
#undef PV_D0
#undef TRRD
}

template <class TIn, class TOut> struct BlockRef { const TIn* Q; const TIn* K; const TIn* V; TOut* O; int P0; };
template <class TIn> struct Seam {
    bf16x8 qr[8];
    bf16x8 st_v0, st_v1, st_k0, st_k1; f32x4 sf0, sf1, sf2, sf3;
    f32x4 tq[16];
};
__device__ __forceinline__ int swa_jlo(int P0, int W) { const int lowk = P0 - W + 1; return lowk > 0 ? lowk / KVBLK : 0; }
#define ROW(p, k0, rr) ((p) + (size_t)((k0) + (rr)) * LDR + sc)
#define VMW() asm volatile("s_waitcnt vmcnt(0)" ::: "memory")
#define VMWN(n) asm volatile("s_waitcnt vmcnt(%0)" :: "i"(n) : "memory")
#define SLOAD_H(Kp, Vp, k0) do { S.st_v0 = load8<TIn>(ROW(Vp, k0, sr)); S.st_v1 = load8<TIn>(ROW(Vp, k0, 32 + sr));              \
                         S.st_k0 = load8<TIn>(ROW(Kp, k0, sr)); S.st_k1 = load8<TIn>(ROW(Kp, k0, 32 + sr)); } while (0)
#define SWRITE_HK(bf) do { *(bf16x8*)(K_lds + (bf) * SHM_K + kws) = S.st_k0; *(bf16x8*)(K_lds + (bf) * SHM_K + kws + 32 * 256) = S.st_k1; } while (0)
#define SWRITE_HV(bf) do { *(bf16x8*)(V_lds + (bf) * SHM_V + vst0) = S.st_v0; *(bf16x8*)(V_lds + (bf) * SHM_V + vst1) = S.st_v1; } while (0)
#define SWRITE_H(bf) do { SWRITE_HV(bf); SWRITE_HK(bf); } while (0)
#define SLOAD_F(p, k0) do { S.sf0 = *(const f32x4*)ROW(p, k0, sr); S.sf1 = *(const f32x4*)(ROW(p, k0, sr) + 4);                \
                            S.sf2 = *(const f32x4*)ROW(p, k0, 32 + sr); S.sf3 = *(const f32x4*)(ROW(p, k0, 32 + sr) + 4); } while (0)
#define SWRITE_KF(bf) do { *(bf16x8*)(K_lds + (bf) * SHM_K + kws) = pack8(S.sf0, S.sf1); *(bf16x8*)(K_lds + (bf) * SHM_K + kws + 32 * 256) = pack8(S.sf2, S.sf3); } while (0)
#define SWRITE_VF(bf) do { *(bf16x8*)(V_lds + (bf) * SHM_V + vst0) = pack8(S.sf0, S.sf1); *(bf16x8*)(V_lds + (bf) * SHM_V + vst1) = pack8(S.sf2, S.sf3); } while (0)
template <class TIn, class TOut>
__device__ __forceinline__ void causal_swa_prime(const BlockRef<TIn, TOut>& cur, int W, char* lds, Seam<TIn>& S) {
    constexpr bool F32 = same_t<TIn, float>::v;
    const int tid = threadIdx.x, wid = __builtin_amdgcn_readfirstlane(tid >> 6), lane = tid & 63, r32 = lane & 31, hi = lane >> 5;
    const int sr = tid >> 4, sc = (tid & 15) * 8, kws = KSWZ(sr, sc * 2); char* K_lds = lds + 2 * SHM_V;
    const int kb0 = swa_jlo(cur.P0, W) * KVBLK;
    for (int d0 = 0; d0 < 8; ++d0) S.qr[d0] = load8<TIn>(cur.Q + (size_t)(wid * QBLK + r32) * LDR + d0 * 16 + hi * 8);
    if constexpr (F32) { SLOAD_F((const float*)cur.K, kb0); VMW(); SWRITE_KF(0); SBAR(); SLOAD_F((const float*)cur.V, kb0); }
    else { SLOAD_H(cur.K, cur.V, kb0); VMW(); SWRITE_HK(0); }
    __syncthreads();
}
template <class TIn, class TOut>
__device__ __forceinline__ void causal_swa_block(const BlockRef<TIn, TOut>& cur, const BlockRef<TIn, TOut>& nxt, int skv, int W, char* lds, Seam<TIn>& S, const float* nb) {
    constexpr bool F32 = same_t<TIn, float>::v;
    const int tid = threadIdx.x, wid = __builtin_amdgcn_readfirstlane(tid >> 6), lane = tid & 63, r32 = lane & 31, hi = lane >> 5;
    const int j_lo = swa_jlo(cur.P0, W);
    int j_hi = (cur.P0 + QB - 1) / KVBLK + 1; if (j_hi > skv / KVBLK) j_hi = skv / KVBLK;
    const int NT = j_hi - j_lo;
    const int kbn = swa_jlo(nxt.P0, W) * KVBLK;
    const int qlo = cur.P0 + wid * QBLK, qm = qlo + r32 - 4 * hi;
    char* V_lds = lds; char* K_lds = lds + 2 * SHM_V;
    float* ws = (float*)(lds + 2 * SHM_V + 2 * SHM_K) + wid * 64; float* li_l = ws, * al_l = ws + 32;
    float m_reg = -1e30f, l_reg = 0; f32x16 o[4] = {};
    const float mfloor = __builtin_bit_cast(float, __builtin_amdgcn_readfirstlane(__builtin_bit_cast(int, nb[cur.P0 + wid * QBLK])));
    const int sr = tid >> 4, sc = (tid & 15) * 8, vst0 = v_st(sr, sc), vst1 = v_st(32 + sr, sc), kws = KSWZ(sr, sc * 2);
    const int vb0 = (int)(uintptr_t)V_lds + v_rd_base(lane);
    const TIn* Kh = cur.K; const TIn* Vh = cur.V;
#define RESC(a) do { if (__any((a) < 1.f)) { if (hi == 0) al_l[r32] = (a); asm volatile("s_waitcnt lgkmcnt(0)" ::: "memory");              \
                     for (int d_ = 0; d_ < 4; ++d_) for (int r = 0; r < 16; ++r) o[d_][r] *= al_l[crow(r, hi)]; } } while (0)
#define KBASE(t) ((j_lo + (t)) * KVBLK)
#define ACT(t) (KBASE(t) <= qlo + QBLK - 1 && KBASE(t) + KVBLK - 1 >= qlo - W + 1)
#define MASKT(P0_, P1_, t) do { const int kb_ = KBASE(t); if ((!SK || ACT(t)) && (kb_ + KVBLK - 1 > qlo || kb_ <= qlo + QBLK - 1 - W)) mask_tile(P0_, P1_, qm - kb_, (unsigned)W); } while (0)
    constexpr int NQL = F32 ? 16 : 8;
    constexpr bool SK = WSKIP && !F32;
#define SEAM_K0() do { VMWN(NQL); if constexpr (F32) { SWRITE_KF(0); SBAR(); SLOAD_F((const float*)nxt.V, kbn); } else { SWRITE_HK(0); } SBAR(); } while (0)
    f32x16 pA0, pA1, pB0, pB1; float mnA, mnB, alA, alB; bf16x8 pa0, pa1, pa2, pa3;
    if constexpr (F32) { VMW(); SWRITE_VF(0); SBAR(); } else { SWRITE_HV(0); SBAR(); }
    char* qlds = lds + QLDS_OFF + wid * 8192 + lane * 16;
    { _Pragma("unroll") for (int d0 = 0; d0 < 8; ++d0) *reinterpret_cast<bf16x8*>(qlds + d0 * 1024) = S.qr[d0]; }
    SBAR();
    if (NT > 1) { if constexpr (F32) SLOAD_F((const float*)Kh, KBASE(1)); else SLOAD_H(Kh, Vh, KBASE(1)); }
    SBAR(); qkt<0, SK>(pA0, pA1, K_lds, r32, hi, qlds, ACT(0), nb + KBASE(0) + 4 * hi);
    if constexpr (F32) { if (NT > 1) { VMW(); SWRITE_KF(1); SBAR(); SLOAD_F((const float*)Vh, KBASE(1)); } }
    MASKT(pA0, pA1, 0); partialSM(pA0, pA1, m_reg, mnA, alA, mfloor);
    if (NT > 1) { VMW(); if constexpr (F32) { SWRITE_VF(1); SBAR(); if (NT > 2) SLOAD_F((const float*)Kh, KBASE(2)); } else SWRITE_H(1); }
    __syncthreads();
#define HALF_STEP(PX0, PX1, mnX, alX, PY0, PY1, alY, t, KB, VB, SB) do {                                                      \
        SBAR(); qkt<KB, SK>(PX0, PX1, K_lds, r32, hi, qlds, ACT(t), nb + KBASE(t) + 4 * hi);                                             \
        finishSM(PY0, PY1, alY, l_reg, pa0, pa1, pa2, pa3); SBAR();                                                           \
        if ((t) + 1 < NT) { if constexpr (F32) { VMW(); SWRITE_KF(SB); SBAR(); SLOAD_F((const float*)Vh, KBASE((t) + 1)); }  \
                            else { SLOAD_H(Kh, Vh, KBASE((t) + 1)); } SBAR(); }                                               \
        pv_tile<VB, SK>(o, vb0, pa0, pa1, pa2, pa3, ACT((t) - 1)); MASKT(PX0, PX1, (t)); partialSM(PX0, PX1, m_reg, mnX, alX, mfloor);                                        \
        __syncthreads();                                                                                                      \
        if ((t) + 1 < NT) { VMW(); if constexpr (F32) { SWRITE_VF(SB); SBAR(); if ((t) + 2 < NT) SLOAD_F((const float*)Kh, KBASE((t) + 2)); } \
                            else { SWRITE_H(SB); } }                                                                          \
        RESC(alX); __syncthreads(); } while (0)
    for (int t = 1; t + 1 < NT; t += 2) {
        HALF_STEP(pB0, pB1, mnB, alB, pA0, pA1, alA, t, 1, 0, 0);
        HALF_STEP(pA0, pA1, mnA, alA, pB0, pB1, alB, t + 1, 0, 1, 1);
    }
    const bool even = (NT & 1) == 0;
    if (even) { SBAR(); qkt<1, SK>(pB0, pB1, K_lds, r32, hi, qlds, ACT(NT - 1), nb + KBASE(NT - 1) + 4 * hi); SBAR(); }
#define QROW(e) (nxt.Q + (size_t)(wid * QBLK + r32) * LDR + ((e) >> 1) * 16 + hi * 8 + ((e) & 1) * 4)
    if constexpr (F32) { SLOAD_F((const float*)nxt.K, kbn); SBAR();
#pragma unroll
        for (int e = 0; e < 8; ++e) S.tq[e] = *(const f32x4*)QROW(e); }
    else { SLOAD_H(nxt.K, nxt.V, kbn); SBAR();
#pragma unroll
        for (int d0 = 0; d0 < 8; ++d0) S.qr[d0] = load8<TIn>(nxt.Q + (size_t)(wid * QBLK + r32) * LDR + d0 * 16 + hi * 8); }
    SBAR();
    finishSM(pA0, pA1, alA, l_reg, pa0, pa1, pa2, pa3); SBAR();
    if constexpr (F32) {
#pragma unroll
        for (int e = 8; e < 16; ++e) S.tq[e] = *(const f32x4*)QROW(e); SBAR(); }
#undef QROW
    pv_tile<0, SK>(o, vb0, pa0, pa1, pa2, pa3, ACT(even ? NT - 2 : NT - 1));
    if (even) { MASKT(pB0, pB1, NT - 1); partialSM(pB0, pB1, m_reg, mnB, alB, mfloor); __syncthreads(); RESC(alB);
        finishSM(pB0, pB1, alB, l_reg, pa0, pa1, pa2, pa3); SBAR(); pv_tile<1, SK>(o, vb0, pa0, pa1, pa2, pa3, ACT(NT - 1)); }
    SBAR(); SEAM_K0();
    if (hi == 0) li_l[r32] = l_reg; asm volatile("s_waitcnt lgkmcnt(0)" ::: "memory");
    float rli[16];
#pragma unroll
    for (int r = 0; r < 16; ++r) rli[r] = __builtin_amdgcn_rcpf(li_l[crow(r, hi)]);
    TOut* Ow = cur.O + (size_t)(wid * QBLK) * LDR;
#pragma unroll
    for (int r = 0; r < 16; ++r) { const int orow = crow(r, hi);
#pragma unroll
        for (int d0 = 0; d0 < 4; ++d0) { const float v = o[d0][r] * rli[r];
            if constexpr (same_t<TOut, float>::v) { Ow[(size_t)orow * LDR + d0 * 32 + r32] = v; }
            else { const float vn = __shfl_xor(v, 1);
                   if ((r32 & 1) == 0) *(unsigned*)(Ow + (size_t)orow * LDR + d0 * 32 + r32) = cvtpk(v, vn); } } }
    if constexpr (F32) {
#pragma unroll
        for (int d0 = 0; d0 < 8; ++d0) S.qr[d0] = pack8(S.tq[2 * d0], S.tq[2 * d0 + 1]); }
    __syncthreads();
#undef RESC
#undef KBASE
#undef ACT
#undef MASKT
#undef SEAM_K0
#undef HALF_STEP
}
#undef ROW
#undef VMW
#undef VMWN
#undef SLOAD_H
#undef SWRITE_HK
#undef SWRITE_HV
#undef SWRITE_H
#undef SLOAD_F
#undef SWRITE_KF
#undef SWRITE_VF

}
constexpr int M_TOK = 8192, DMODEL = 2048, DFF = 8192, SEQ = 2048, NBATCH = 4, NHEAD = 16, HDIM = 128, PLE = 256;
constexpr int NWAVES = 8, NTHREADS = 512;
constexpr int LDS_BYTES = 147456;
constexpr int LDS_MISC_OFF = 147456 - 64;
#define LAS __attribute__((address_space(3)))
typedef unsigned short bf16_t;
typedef float f32x4 __attribute__((ext_vector_type(4)));
typedef unsigned v4u __attribute__((ext_vector_type(4)));
typedef unsigned v2u __attribute__((ext_vector_type(2)));

constexpr size_t MiB = 1u << 20;
constexpr size_t WS_SS = 1536 * 1024;
constexpr size_t WS_RS0 = 256 * 1024;
constexpr size_t WS_LB = 320 * 1024;
constexpr size_t WS_BAR = 512 * 1024;
constexpr size_t WS_FL = 1 * MiB;
constexpr size_t WS_WUP0 = 2 * MiB, WS_WDN0 = 34 * MiB, WS_WG0 = 66 * MiB, WS_WPU = 74 * MiB;
constexpr size_t WS_HB0 = 76 * MiB, WS_HB1 = 108 * MiB, WS_PU = 140 * MiB;
constexpr size_t WS_B = 204 * MiB;
constexpr size_t WS_WIN = WS_B, WS_WAOUT = WS_B + 32 * MiB, WS_XB = WS_B + 40 * MiB, WS_OG = WS_XB, WS_QIN = WS_B + 72 * MiB, WS_KIN = WS_B + 104 * MiB, WS_KEND = WS_B + 136 * MiB,
                 WS_V0 = WS_B + 168 * MiB, WS_SG = WS_B + 200 * MiB, WS_PB = WS_B + 232 * MiB, WS_DEC = WS_B + 240 * MiB;
constexpr size_t WS_HID = WS_B, WS_WG1 = WS_B + 192 * MiB, WS_WKVQ = WS_B + 200 * MiB, WS_WBOUT = WS_B + 224 * MiB;
constexpr size_t WS_WUP1 = WS_B + 244 * MiB, WS_WDN1 = WS_B + 276 * MiB;
constexpr size_t WS_KB = WS_B, WS_VB = WS_B + 32 * MiB, WS_QB = WS_B + 64 * MiB, WS_AO = WS_B + 96 * MiB;
constexpr size_t WS_END = WS_B + 308 * MiB;

struct Params { const float* in[19]; float* out; unsigned char* ws; int ph_lo, ph_hi, coop, pad; };
enum { I_X = 0, I_P, I_MIXN, I_MLPN, I_PLEN, I_WAIN, I_LBL, I_HGAIN, I_WAOUT, I_KVN, I_WKVF, I_BF, I_WBQ, I_WBOUT, I_WUP, I_WDN, I_WG, I_WPU, I_FINN };

__device__ __forceinline__ float wave_sum(float v) {
#pragma unroll
    for (int o = 1; o < 64; o <<= 1) v += __shfl_xor(v, o);
    return v;
}
__device__ __forceinline__ unsigned f2bf(float f) { unsigned u = __builtin_bit_cast(unsigned, f); return (u + 0x7fffu + ((u >> 16) & 1u)) >> 16; }
__device__ __forceinline__ unsigned pk2(float lo, float hi) { return f2bf(lo) | (f2bf(hi) << 16); }
__device__ __forceinline__ float bf2f(bf16_t v) { return __uint_as_float((unsigned)v << 16); }

__device__ __forceinline__ void tr_load(const float* W, int ld, const float* gain, int gmask, int k0, int n0, int lane, float (&v)[32]) {
#pragma unroll
    for (int i = 0; i < 32; ++i) { const int kk = 2 * i + (lane >> 5); v[i] = __builtin_nontemporal_load(W + (size_t)(k0 + kk) * ld + n0 + (lane & 31)); }
    (void)gain; (void)gmask;
}
__device__ __forceinline__ void tr_put(LAS float* scr, int lane, const float (&v)[32]) {
#pragma unroll
    for (int i = 0; i < 32; ++i) { const int kk = 2 * i + (lane >> 5); scr[kk * 33 + (lane & 31)] = v[i]; }
    asm volatile("s_waitcnt lgkmcnt(0)" ::: "memory");
}
__device__ __forceinline__ void tr_out(bf16_t* WT, int K, int drow0, LAS float* scr, int k0, int lane, const float* gain, int gmask) {
    const int c = lane & 7;
    f32x4 g0 = (f32x4){1.f, 1.f, 1.f, 1.f}, g1 = g0;
    if (gain) { const float* gp = gain + ((k0 + 8 * c) & gmask); g0 = *(const f32x4*)gp; g1 = *(const f32x4*)(gp + 4); }
#pragma unroll
    for (int j = 0; j < 4; ++j) { const int n = (lane >> 3) + 8 * j; const LAS float* s = scr + (8 * c) * 33 + n;
        v4u o; o.x = pk2(s[0 * 33] * g0[0], s[1 * 33] * g0[1]); o.y = pk2(s[2 * 33] * g0[2], s[3 * 33] * g0[3]); o.z = pk2(s[4 * 33] * g1[0], s[5 * 33] * g1[1]); o.w = pk2(s[6 * 33] * g1[2], s[7 * 33] * g1[3]);
        __builtin_nontemporal_store(o, (v4u*)(WT + (size_t)(drow0 + n) * K + k0 + 8 * c)); }
    asm volatile("s_waitcnt lgkmcnt(0)" ::: "memory");
}
template <int MODE = 0>
__device__ __forceinline__ void tr_job(const float* W, int K, int N, int ld, const float* gain, int gmask, bf16_t* WT, int drow_off, LAS float* scr, int gw, int NGW, int lane) {
    const int nblk = N / 32, nitems = (K / 64) * nblk;
    float v[32];
    int it = gw;
    if (it < nitems) { const int kb = it / nblk, nb = it - kb * nblk; tr_load(W, ld, gain, gmask, 64 * kb, 32 * nb, lane, v); }
    for (; it < nitems; it += NGW) { const int kb = it / nblk, nb = it - kb * nblk; const int n0 = 32 * nb; int drow = drow_off + n0;
        if (MODE == 1) { const int r = n0 >> 11, hh = (n0 >> 7) & 15, dd = n0 & 127; drow = 256 * (2 * hh + ((r >> 1) ^ ((hh >> 1) & 1))) + 128 * (r & 1) + dd; }
        tr_put(scr, lane, v);
        const int itn = it + NGW;
        if (itn < nitems) { const int kbn = itn / nblk, nbn = itn - kbn * nblk; tr_load(W, ld, gain, gmask, 64 * kbn, 32 * nbn, lane, v); }
        tr_out(WT, K, drow, scr, 64 * kb, lane, gain, gmask); }
}

__device__ __forceinline__ void phase_prologue(const Params& P, LAS unsigned char* lds) {
    const int tid = threadIdx.x, lane = tid & 63, wave = tid >> 6; const int gw = blockIdx.x * NWAVES + wave, NGW = gridDim.x * NWAVES;
    LAS float* scr = (LAS float*)(lds + wave * 16384);
    unsigned char* ws = P.ws;
    tr_job<1>(P.in[I_WAIN], 2048, 8192, 8192, P.in[I_MIXN], 0x7fffffff, (bf16_t*)(ws + WS_WIN), 0, scr, gw, NGW, lane);
    tr_job(P.in[I_WPU], 256, 2048, 2048, nullptr, 0, (bf16_t*)(ws + WS_WPU), 0, scr, gw, NGW, lane);
    tr_job(P.in[I_WPU] + 256 * 2048, 256, 2048, 2048, nullptr, 0, (bf16_t*)(ws + WS_WPU) + 2048 * 256, 0, scr, gw, NGW, lane);
    const float* x = P.in[I_X]; bf16_t* xb = (bf16_t*)(ws + WS_XB); float* rs0 = (float*)(ws + WS_RS0);
    for (int r = gw; r < M_TOK; r += NGW) { const f32x4* xr = (const f32x4*)(x + (size_t)r * DMODEL) + lane; float s = 0.f; f32x4 v[8];
#pragma unroll
        for (int j = 0; j < 8; ++j) { v[j] = __builtin_nontemporal_load(xr + 64 * j); s += (v[j][0] * v[j][0] + v[j][1] * v[j][1]) + (v[j][2] * v[j][2] + v[j][3] * v[j][3]); }
        s = wave_sum(s); if (lane == 0) rs0[r] = rsqrtf(s * (1.0f / 2048.0f) + 1e-6f);
        v2u* o = (v2u*)(xb + (size_t)r * DMODEL) + lane;
#pragma unroll
        for (int j = 0; j < 8; ++j) { v2u w; w.x = pk2(v[j][0], v[j][1]); w.y = pk2(v[j][2], v[j][3]); o[64 * j] = w; } }
    const int gt = blockIdx.x * NTHREADS + tid, NGT = gridDim.x * NTHREADS;
    { const f32x4* p4 = (const f32x4*)P.in[I_P]; v2u* pb = (v2u*)(ws + WS_PB);
      for (int i = gt; i < 2 * M_TOK * PLE / 4; i += NGT) { const f32x4 v = __builtin_nontemporal_load(p4 + i); v2u w; w.x = pk2(v[0], v[1]); w.y = pk2(v[2], v[3]); pb[i] = w; } }
    { const float* l = P.in[I_LBL]; float* lb = (float*)(ws + WS_LB); for (int i = gt; i < DMODEL; i += NGT) lb[i] = 1.0f / (1.0f + __expf(l[DMODEL + i] - l[i])); }
    { long long* ss = (long long*)(ws + WS_SS); for (int i = gt; i < 6 * M_TOK; i += NGT) ss[i] = 0ll; }
}
__device__ __forceinline__ void phase_weights1(const Params& P, LAS unsigned char* lds) {
    const int tid = threadIdx.x, lane = tid & 63, wave = tid >> 6; const int gw = blockIdx.x * NWAVES + wave, NGW = gridDim.x * NWAVES;
    LAS float* scr = (LAS float*)(lds + wave * 16384);
    unsigned char* ws = P.ws;
    tr_job(P.in[I_WG] + (size_t)2048 * 2048, 2048, 2048, 2048, P.in[I_PLEN] + 2048, 0x7fffffff, (bf16_t*)(ws + WS_WG1), 0, scr, gw, NGW, lane);
    asm volatile("s_waitcnt vmcnt(0) lgkmcnt(0)" ::: "memory"); __syncthreads();
}

typedef short s16x4 __attribute__((ext_vector_type(4)));
typedef short s16x8 __attribute__((ext_vector_type(8)));
constexpr int SC_RS = 264, SC_TILE = 16 * SC_RS, SC_CH = 5 * SC_TILE + 512, SC_G = 2, SC_BUF = SC_G * SC_CH, SC_SP = 2 * SC_BUF  , SC_KT = SC_SP + 1024  ;
typedef float f32x2_t __attribute__((ext_vector_type(2))); typedef __bf16 bf16x2_t __attribute__((ext_vector_type(2)));
__device__ __forceinline__ unsigned cvtpk_bf16(float lo, float hi) { f32x2_t v = {lo, hi}; bf16x2_t b = __builtin_convertvector(v, bf16x2_t); return __builtin_bit_cast(unsigned, b); }
template <int CTRL> __device__ __forceinline__ float sc_dpp(float x) { return __builtin_bit_cast(float, __builtin_amdgcn_update_dpp(0, __builtin_bit_cast(int, x), CTRL, 0xf, 0xf, true)); }
__device__ __forceinline__ void phase_scan(const Params& P, LAS unsigned char* lds) {
    const int tid = threadIdx.x, lane = tid & 63, w = __builtin_amdgcn_readfirstlane(tid >> 6), l15 = lane & 15, kg = lane >> 4;
    unsigned char* ws = P.ws;
    const int nscan = NBATCH * NHEAD;
    const bool split = (int)gridDim.x > nscan;
    if (!split || (int)blockIdx.x < nscan) {
        const bf16_t* QIN = (const bf16_t*)(ws + WS_QIN); const bf16_t* KIN = (const bf16_t*)(ws + WS_KIN);
        const bf16_t* V0 = (const bf16_t*)(ws + WS_V0); const bf16_t* SG = (const bf16_t*)(ws + WS_SG); const float* DEC = (const float*)(ws + WS_DEC);
        bf16_t* OG = (bf16_t*)P.out;
        const int stok = tid >> 5, d4 = (tid & 31) * 4;
        LAS float* sp = (LAS float*)(lds + SC_SP);
        for (int item = blockIdx.x; item < nscan; item += (split ? nscan : (int)gridDim.x)) {
            const int b = item >> 4, h = item & 15;
            f32x4 S[8];
#pragma unroll
            for (int dt = 0; dt < 8; ++dt) S[dt] = (f32x4){0.f, 0.f, 0.f, 0.f};
            v2u rq[2][SC_G], rk[2][SC_G], rv[2][SC_G], rg[2][SC_G]; float rd[2][SC_G];
#define SC_LOAD(st, g) do { _Pragma("unroll") for (int c2 = 0; c2 < SC_G; ++c2) { const int ch = b * 128 + (g) * SC_G + c2; const size_t off = (size_t)(ch * 16 + stok) * DMODEL + h * HDIM + d4; \
                rq[st][c2] = __builtin_nontemporal_load((const v2u*)(QIN + off)); rk[st][c2] = __builtin_nontemporal_load((const v2u*)(KIN + off)); rv[st][c2] = __builtin_nontemporal_load((const v2u*)(V0 + off)); rg[st][c2] = __builtin_nontemporal_load((const v2u*)(SG + off)); \
                rd[st][c2] = (tid < 128) ? DEC[(size_t)ch * DMODEL + h * HDIM + tid] : 0.f; } } while (0)
#define SC_WRITE(st, bi) do { _Pragma("unroll") for (int c2 = 0; c2 < SC_G; ++c2) { LAS unsigned char* cbw = lds + (bi) * SC_BUF + c2 * SC_CH + stok * SC_RS + d4 * 2; \
                *(LAS v2u*)(cbw) = rq[st][c2]; *(LAS v2u*)(cbw + SC_TILE) = rk[st][c2]; *(LAS v2u*)(cbw + 3 * SC_TILE) = rv[st][c2]; *(LAS v2u*)(cbw + 4 * SC_TILE) = rg[st][c2]; \
                if (tid < 128) *(LAS float*)(lds + (bi) * SC_BUF + c2 * SC_CH + 5 * SC_TILE + tid * 4) = rd[st][c2]; } } while (0)
            SC_LOAD(0, 0); SC_WRITE(0, 0); SC_LOAD(1, 1); SC_LOAD(0, 2);
            __syncthreads();
            constexpr int NG = (SEQ / 16) / SC_G;
            for (int g2 = 0; g2 < NG; g2 += 2) {
#pragma unroll
              for (int par = 0; par < 2; ++par) { const int g = g2 + par;
#pragma unroll
                for (int cc = 0; cc < SC_G; ++cc) {
                    const int n = g * SC_G + cc;
                    const LAS unsigned char* cb = lds + par * SC_BUF + cc * SC_CH;
                    s16x8 qA[4], kA[4];
#pragma unroll
                    for (int ks = 0; ks < 4; ++ks) { const LAS unsigned char* p = cb + l15 * SC_RS + (32 * ks + 4 * kg) * 2;
                        const v2u qlo = *(const LAS v2u*)p, qhi = *(const LAS v2u*)(p + 32), klo = *(const LAS v2u*)(p + SC_TILE), khi = *(const LAS v2u*)(p + SC_TILE + 32);
                        qA[ks] = __builtin_bit_cast(s16x8, (v4u){qlo.x, qlo.y, qhi.x, qhi.y}); kA[ks] = __builtin_bit_cast(s16x8, (v4u){klo.x, klo.y, khi.x, khi.y}); }
                    s16x8 vB = (s16x8){0, 0, 0, 0, 0, 0, 0, 0};
#pragma unroll
                    for (int j = 0; j < 4; ++j) vB[j] = *(const LAS short*)(cb + 3 * SC_TILE + (4 * kg + j) * SC_RS + (16 * w + l15) * 2);
                    const f32x4 z4 = (f32x4){0.f, 0.f, 0.f, 0.f};
                    f32x4 at0 = __builtin_amdgcn_mfma_f32_16x16x32_bf16(kA[0], qA[0], z4, 0, 0, 0);
                    f32x4 at1 = __builtin_amdgcn_mfma_f32_16x16x32_bf16(kA[1], qA[1], z4, 0, 0, 0);
                    s16x8 Sb[4];
#pragma unroll
                    for (int ks = 0; ks < 4; ++ks) Sb[ks] = __builtin_bit_cast(s16x8, (v4u){cvtpk_bf16(S[2 * ks][0], S[2 * ks][1]), cvtpk_bf16(S[2 * ks][2], S[2 * ks][3]),
                                                                                           cvtpk_bf16(S[2 * ks + 1][0], S[2 * ks + 1][1]), cvtpk_bf16(S[2 * ks + 1][2], S[2 * ks + 1][3])});
                    f32x4 os0 = __builtin_amdgcn_mfma_f32_16x16x32_bf16(qA[0], Sb[0], z4, 0, 0, 0);
                    f32x4 os1 = __builtin_amdgcn_mfma_f32_16x16x32_bf16(qA[1], Sb[1], z4, 0, 0, 0);
                    at0 = __builtin_amdgcn_mfma_f32_16x16x32_bf16(kA[2], qA[2], at0, 0, 0, 0);
                    at1 = __builtin_amdgcn_mfma_f32_16x16x32_bf16(kA[3], qA[3], at1, 0, 0, 0);
                    os0 = __builtin_amdgcn_mfma_f32_16x16x32_bf16(qA[2], Sb[2], os0, 0, 0, 0);
                    os1 = __builtin_amdgcn_mfma_f32_16x16x32_bf16(qA[3], Sb[3], os1, 0, 0, 0);
                    f32x4 at = at0 + at1;
#pragma unroll
                    for (int i = 0; i < 4; ++i) if (4 * kg + i > l15) at[i] = 0.f;
                    const s16x8 attA = __builtin_bit_cast(s16x8, (v4u){cvtpk_bf16(at[0], at[1]), cvtpk_bf16(at[2], at[3]), 0u, 0u});
                    const f32x4 o = __builtin_amdgcn_mfma_f32_16x16x32_bf16(attA, vB, os0 + os1, 0, 0, 0);
                    { s16x4 kf;
#pragma unroll
                      for (int j = 0; j < 4; ++j) kf[j] = *(const LAS short*)(cb + 1 * SC_TILE + (4 * kg + j) * SC_RS + (16 * w + l15) * 2);
                      *(LAS s16x4*)(lds + SC_KT + ((n & 1) * 8 + w) * 512 + lane * 8) = kf; }
                    f32x4 sq = o * o;
#pragma unroll
                    for (int i = 0; i < 4; ++i) { float x = sq[i]; x += sc_dpp<0xB1>(x); x += sc_dpp<0x4E>(x); x += sc_dpp<0x141>(x); x += sc_dpp<0x140>(x); sq[i] = x; }
                    if (l15 == 0) *(LAS f32x4*)(sp + ((n & 1) * 8 + w) * 16 + kg * 4) = sq;
                    if (cc == SC_G - 1 && g + 1 < NG) SC_WRITE(1 - par, 1 - par);
                    __syncthreads();
                    f32x4 tot = (f32x4){0.f, 0.f, 0.f, 0.f};
#pragma unroll
                    for (int ww = 0; ww < 8; ++ww) tot += *(const LAS f32x4*)(sp + ((n & 1) * 8 + ww) * 16 + kg * 4);
#pragma unroll
                    for (int dt = 0; dt < 8; ++dt) { s16x8 keA = (s16x8){0, 0, 0, 0, 0, 0, 0, 0};
                        const s16x4 kf = *(const LAS s16x4*)(lds + SC_KT + ((n & 1) * 8 + dt) * 512 + lane * 8);
                        keA[0] = kf[0]; keA[1] = kf[1]; keA[2] = kf[2]; keA[3] = kf[3];
                        const f32x4 dc = *(const LAS f32x4*)(cb + 5 * SC_TILE + (16 * dt + 4 * kg) * 4);
                        S[dt] = __builtin_amdgcn_mfma_f32_16x16x32_bf16(keA, vB, S[dt], 0, 0, 0) * dc; }
                    const int tok0 = (b * 128 + n) * 16;
#pragma unroll
                    for (int i = 0; i < 4; ++i) { const float r = rsqrtf(tot[i] * (1.0f / 128.0f) + 1e-6f);
                        const bf16_t gv = *(const LAS bf16_t*)(cb + 4 * SC_TILE + (4 * kg + i) * SC_RS + (16 * w + l15) * 2);
                        OG[(size_t)(tok0 + 4 * kg + i) * DMODEL + h * HDIM + 16 * w + l15] = (bf16_t)f2bf(o[i] * r * bf2f(gv)); }
                    if (cc == SC_G - 1 && g + 3 < NG) SC_LOAD(1 - par, g + 3);
                }
              }
            }
            __syncthreads();
#undef SC_LOAD
#undef SC_WRITE
        }
    }
    if (!split || (int)blockIdx.x >= nscan) {
        const int nconv = split ? (int)gridDim.x - nscan : (int)gridDim.x, cid = split ? (int)blockIdx.x - nscan : (int)blockIdx.x;
        const int gw = cid * NWAVES + w, NGW = nconv * NWAVES; LAS float* scr = (LAS float*)(lds + w * 16384);
        tr_job(P.in[I_WAOUT], 2048, 2048, 2048, P.in[I_HGAIN], 127, (bf16_t*)(ws + WS_WAOUT), 0, scr, gw, NGW, lane);
        tr_job(P.in[I_WUP], 2048, 8192, 8192, P.in[I_MLPN], 0x7fffffff, (bf16_t*)(ws + WS_WUP0), 0, scr, gw, NGW, lane);
        tr_job(P.in[I_WDN], 8192, 2048, 2048, nullptr, 0, (bf16_t*)(ws + WS_WDN0), 0, scr, gw, NGW, lane);
        tr_job(P.in[I_WG], 2048, 2048, 2048, P.in[I_PLEN], 0x7fffffff, (bf16_t*)(ws + WS_WG0), 0, scr, gw, NGW, lane);
        tr_job(P.in[I_WUP] + (size_t)2048 * 8192, 2048, 8192, 8192, P.in[I_MLPN] + 2048, 0x7fffffff, (bf16_t*)(ws + WS_WUP1), 0, scr, gw, NGW, lane);
        tr_job(P.in[I_WDN] + (size_t)2048 * 8192, 8192, 2048, 2048, nullptr, 0, (bf16_t*)(ws + WS_WDN1), 0, scr, gw, NGW, lane);
        { bf16_t* WKVQ = (bf16_t*)P.out + (size_t)M_TOK * DMODEL; bf16_t* WBO = WKVQ + (size_t)6144 * 2048;
          tr_job(P.in[I_WKVF], 2048, 4096, 4112, P.in[I_KVN], 0x7fffffff, WKVQ, 0, scr, gw, NGW, lane);
          tr_job(P.in[I_WBQ], 2048, 2048, 2048, P.in[I_MIXN] + 2048, 0x7fffffff, WKVQ, 4096, scr, gw, NGW, lane);
          tr_job(P.in[I_WBOUT], 2048, 2048, 2048, nullptr, 0, WBO, 0, scr, gw, NGW, lane); }
        asm volatile("s_waitcnt vmcnt(0) lgkmcnt(0)" ::: "memory"); __syncthreads();
        for (int l = 0; l < 2; ++l) { pg8::Gemm g{(const bf16_t*)(ws + WS_PB) + (size_t)l * M_TOK * PLE, (const bf16_t*)(ws + WS_WPU) + (size_t)l * 2048 * 256, M_TOK, 2048, 256}; pg8::StaticOrder So; So.init(M_TOK, 2048, nconv, cid);
            pg8::EpiStore E{(bf16_t*)(ws + WS_PU) + (size_t)l * M_TOK * DMODEL, 0, nullptr};
            pg8::gemm_phase<pg8::EpiStore, pg8::StaticOrder, true, true>(lds, g, So, E); }
    }
    asm volatile("s_waitcnt vmcnt(0) lgkmcnt(0)" ::: "memory"); __syncthreads();
}

__device__ __forceinline__ void phase_flogit(const Params& P, LAS unsigned char* lds) {
    const int tid = threadIdx.x, lane = tid & 63, wave = tid >> 6; const int gw = blockIdx.x * NWAVES + wave, NGW = gridDim.x * NWAVES;
    const bf16_t* H = (const bf16_t*)(P.ws + WS_HB0); const pg8::ss_t* ss = (const pg8::ss_t*)(P.ws + WS_SS) + 2 * M_TOK; const float* kvn = P.in[I_KVN]; const float* W = P.in[I_WKVF]; const float* bf = P.in[I_BF];
    float* FL = (float*)(P.ws + WS_FL);
    LAS float* Wl = (LAS float*)lds;
    for (int idx = tid; idx < 2048 * 4; idx += NTHREADS) { const int k = idx >> 2, jq = idx & 3; const float g = kvn[k]; const f32x4 w = *(const f32x4*)(W + (size_t)k * 4112 + 4096 + 4 * jq);
#pragma unroll
        for (int i = 0; i < 4; ++i) Wl[(4 * jq + i) * 2048 + k] = w[i] * g; }
    __syncthreads();
    for (int r4 = gw; r4 < M_TOK / 4; r4 += NGW) {
        float acc[4][16];
#pragma unroll
        for (int a = 0; a < 4; ++a)
#pragma unroll
            for (int j = 0; j < 16; ++j) acc[a][j] = 0.f;
#pragma unroll 2
        for (int t = 0; t < 8; ++t) { const int k4 = 4 * lane + 256 * t; f32x4 hv[4];
#pragma unroll
            for (int a = 0; a < 4; ++a) { const v2u hw = __builtin_nontemporal_load((const v2u*)(H + (size_t)(4 * r4 + a) * DMODEL + k4));
                hv[a] = (f32x4){__uint_as_float(hw.x << 16), __uint_as_float(hw.x & 0xffff0000u), __uint_as_float(hw.y << 16), __uint_as_float(hw.y & 0xffff0000u)}; }
#pragma unroll
            for (int j = 0; j < 16; ++j) { const f32x4 w = *(const LAS f32x4*)(Wl + j * 2048 + k4);
#pragma unroll
                for (int a = 0; a < 4; ++a) acc[a][j] += (hv[a][0] * w[0] + hv[a][1] * w[1]) + (hv[a][2] * w[2] + hv[a][3] * w[3]); } }
#pragma unroll
        for (int a = 0; a < 4; ++a) { const int row = 4 * r4 + a; const float rs = pg8::ss_rs(ss, row); float mine = 0.f;
#pragma unroll
            for (int j = 0; j < 16; ++j) { const float v = wave_sum(acc[a][j]); if (lane == j) mine = v; }
            if (lane < 16) { const float xv = mine * rs + bf[lane]; const float ls = (xv >= 0.f) ? -log1pf(expf(-xv)) : (xv - log1pf(expf(xv)));
                const int b = row / SEQ, s = row - b * SEQ; FL[((size_t)(b * NHEAD + lane)) * SEQ + s] = ls; } }
    }
    __syncthreads();
}

constexpr int ATT_NB_OFF = 69632;
__device__ __forceinline__ void phase_attention(const Params& P, unsigned char* lds_g) {
    using namespace attn;
    const int tid = threadIdx.x, lane = tid & 63, wave = tid >> 6;
    const bf16* Q = (const bf16*)(P.ws + WS_QB); const bf16* K = (const bf16*)(P.ws + WS_KB); const bf16* V = (const bf16*)(P.ws + WS_VB); bf16* O = (bf16*)(P.ws + WS_AO);
    const float* FL = (const float*)(P.ws + WS_FL);
    float* nb = (float*)(lds_g + ATT_NB_OFF); float* wsum = nb + 2048;
    const int total = NBATCH * NHEAD * 4;
    for (int L = blockIdx.x; L < total; L += gridDim.x) {
        const int bh = L >> 2, y = L & 3, b = bh >> 4, h = bh & 15;
        { const f32x4 v = *(const f32x4*)(FL + (size_t)bh * SEQ + 4 * tid); float p0 = v[0], p1 = p0 + v[1], p2 = p1 + v[2], p3 = p2 + v[3];
          float incl = p3;
#pragma unroll
          for (int o = 1; o < 64; o <<= 1) { const float t = __shfl_up(incl, o); if (lane >= o) incl += t; }
          if (lane == 63) wsum[wave] = incl;
          __syncthreads();
          float base = incl - p3; for (int w = 0; w < wave; ++w) base += wsum[w];
          const float sc = -11.313708498984761f;
          *(f32x4*)(nb + 4 * tid) = (f32x4){(base + p0) * sc, (base + p1) * sc, (base + p2) * sc, (base + p3) * sc};
          __syncthreads(); }
        const size_t rowb = (size_t)b * SEQ * DMODEL + (size_t)h * HDIM;
        BlockRef<bf16, bf16> r0, r1;
        r0.Q = Q + rowb + (size_t)(y * QB) * DMODEL; r0.O = O + rowb + (size_t)(y * QB) * DMODEL; r0.K = K + rowb; r0.V = V + rowb; r0.P0 = y * QB;
        const int y1 = 7 - y;
        r1.Q = Q + rowb + (size_t)(y1 * QB) * DMODEL; r1.O = O + rowb + (size_t)(y1 * QB) * DMODEL; r1.K = K + rowb; r1.V = V + rowb; r1.P0 = y1 * QB;
        Seam<bf16> S;
        causal_swa_prime<bf16, bf16>(r0, 1 << 30, (char*)lds_g, S);
        causal_swa_block<bf16, bf16>(r0, r1, SEQ, 1 << 30, (char*)lds_g, S, nb);
        causal_swa_block<bf16, bf16>(r1, r1, SEQ, 1 << 30, (char*)lds_g, S, nb);
        asm volatile("s_waitcnt vmcnt(0) lgkmcnt(0)" ::: "memory"); __syncthreads();
    }
}

__device__ __forceinline__ void phase_final(const Params& P) {
    const int tid = threadIdx.x, lane = tid & 63, wave = tid >> 6; const int gw = blockIdx.x * NWAVES + wave, NGW = gridDim.x * NWAVES;
    const pg8::ss_t* ss = (const pg8::ss_t*)(P.ws + WS_SS) + 5 * M_TOK; const f32x4* g4 = (const f32x4*)P.in[I_FINN];
    const bf16_t* H = (const bf16_t*)(P.ws + WS_HB1);
    for (int r = gw; r < M_TOK; r += NGW) { const float rs = pg8::ss_rs(ss, r); const v4u* hr = (const v4u*)(H + (size_t)r * DMODEL) + lane; f32x4* o = (f32x4*)(P.out + (size_t)r * DMODEL) + 2 * lane;
#pragma unroll
        for (int j = 0; j < 4; ++j) { const v4u w = __builtin_nontemporal_load(hr + 64 * j); const f32x4 ga = g4[2 * lane + 128 * j], gb = g4[2 * lane + 128 * j + 1];
            const f32x4 a = (f32x4){__uint_as_float(w.x << 16), __uint_as_float(w.x & 0xffff0000u), __uint_as_float(w.y << 16), __uint_as_float(w.y & 0xffff0000u)};
            const f32x4 b = (f32x4){__uint_as_float(w.z << 16), __uint_as_float(w.z & 0xffff0000u), __uint_as_float(w.w << 16), __uint_as_float(w.w & 0xffff0000u)};
            __builtin_nontemporal_store(a * rs * ga, o + 128 * j); __builtin_nontemporal_store(b * rs * gb, o + 128 * j + 1); } }
}

#define RLX_AGENT __ATOMIC_RELAXED, __HIP_MEMORY_SCOPE_AGENT


#define XB_TMO      128
#define XB_XCNT(j)  (256  + 64 * (j))
#define XB_XSUB(j)  (1280 + 64 * (j))
#define XB_XGEN(j)  (2304 + 64 * (j))
#define XB_TOP      3328
#define XB_TOPGEN   3392
#define XCD_BAR_WORDS 3456
#define XB_SPIN_CAP (1u << 18)

__device__ __forceinline__ unsigned xb_ld(unsigned* p)              { return __hip_atomic_load(p, __ATOMIC_RELAXED, __HIP_MEMORY_SCOPE_AGENT); }
__device__ __forceinline__ unsigned xb_add(unsigned* p, unsigned v) { return __hip_atomic_fetch_add(p, v, __ATOMIC_RELAXED, __HIP_MEMORY_SCOPE_AGENT); }
__device__ __forceinline__ unsigned xb_xcc_id() { return (unsigned)__builtin_amdgcn_s_getreg((3 << 11) | 20) & 0xFu; }
#define XB_SPIN(cond, bar) do { unsigned _sp = 0; while (cond) { __builtin_amdgcn_s_sleep(1); \
    if ((++_sp & 255u) == 0u) { if (xb_ld(&(bar)[XB_TMO])) break; if (_sp > XB_SPIN_CAP) { atomicAdd(&(bar)[XB_TMO], 1u); break; } } } } while (0)

struct XcdBarrier {
    unsigned* bar; unsigned x;
    volatile LAS unsigned* st;
};

__device__ __forceinline__ XcdBarrier xcd_barrier_post(unsigned* bar, volatile LAS unsigned* st) {
    XcdBarrier b; b.bar = bar; b.x = xb_xcc_id(); b.st = st;
    if (threadIdx.x == 0) (void)xb_add(&bar[XB_XCNT(b.x)], 1u);
    return b;
}
__device__ __forceinline__ void xcd_barrier_complete(unsigned* bar, unsigned x, unsigned& nloc, unsigned& nx) {
    const unsigned G = gridDim.x * gridDim.y * gridDim.z;
    unsigned sum, cnt, mine, sp = 0u;
    for (;;) {
        sum = 0u; cnt = 0u; mine = 0u;
#pragma unroll
        for (unsigned j = 0; j < 16; ++j) { const unsigned c = xb_ld(&bar[XB_XCNT(j)]); sum += c; cnt += (c > 0u) ? 1u : 0u; mine = (j == x) ? c : mine; }
        if (sum == G) break;
        __builtin_amdgcn_s_sleep(1);
        if ((++sp & 255u) == 0u) { if (xb_ld(&bar[XB_TMO])) break; if (sp > XB_SPIN_CAP) { atomicAdd(&bar[XB_TMO], 1u); break; } }
    }
    nloc = mine > 0u ? mine : 1u; nx = cnt > 0u ? cnt : 1u;
}

__device__ __forceinline__ void xcd_barrier(const XcdBarrier& b) {
    asm volatile("s_waitcnt vmcnt(0)" ::: "memory");
    __syncthreads();
    if (threadIdx.x == 0) {
        unsigned* bar = b.bar;
        __builtin_amdgcn_s_waitcnt(0);
        unsigned nloc = b.st[0], nx = b.st[1];
        if (nloc == 0u) { xcd_barrier_complete(bar, b.x, nloc, nx); b.st[0] = nloc; b.st[1] = nx; }
        const unsigned old = xb_add(&bar[XB_XSUB(b.x)], 1u);
        const unsigned gen = old / nloc;
        if (old + 1u == (gen + 1u) * nloc) {
            __builtin_amdgcn_fence(__ATOMIC_RELEASE, "agent");
            asm volatile("s_waitcnt vmcnt(0)" ::: "memory");
            const unsigned og = xb_add(&bar[XB_TOP], 1u);
            const unsigned tg = og / nx;
            if (og + 1u == (tg + 1u) * nx) xb_add(&bar[XB_TOPGEN], 1u);
            else XB_SPIN(xb_ld(&bar[XB_TOPGEN]) == tg, bar);
            __builtin_amdgcn_fence(__ATOMIC_ACQUIRE, "agent");
            xb_add(&bar[XB_XGEN(b.x)], 1u);
            asm volatile("s_waitcnt vmcnt(0)" ::: "memory");
        } else {
            XB_SPIN(xb_ld(&bar[XB_XGEN(b.x)]) == gen, bar);
            __builtin_amdgcn_fence(__ATOMIC_ACQUIRE, "agent");
            asm volatile("s_waitcnt vmcnt(0)" ::: "memory");
        }
    }
    __syncthreads();
}

constexpr int NPHASES = 14;
__global__ void __launch_bounds__(NTHREADS, 2) fwd(Params P) {
    extern __shared__ __attribute__((aligned(16))) unsigned char lds_raw[];
    LAS unsigned char* lds = (LAS unsigned char*)lds_raw;
    unsigned char* ws = P.ws;
    const int lo = P.ph_lo, hi = P.ph_hi;
#define IN(k) (lo <= (k) && (k) < hi)
#define SEAM(k) do { if (IN(k) && IN((k) + 1)) { xcd_barrier(bar); } } while (0)
    XcdBarrier bar; bar.bar = (unsigned*)(ws + WS_BAR); bar.x = 0; bar.st = nullptr;
    if (P.coop) {
        if (blockIdx.x == 0) for (int i = threadIdx.x; i < XCD_BAR_WORDS; i += NTHREADS) ((unsigned*)(ws + WS_BAR))[i] = 0u;
        if (threadIdx.x < 2) ((volatile LAS unsigned*)(lds + LDS_MISC_OFF))[threadIdx.x] = 0u;
        __syncthreads();
        cg::this_grid().sync();
        bar = xcd_barrier_post((unsigned*)(ws + WS_BAR), (volatile LAS unsigned*)(lds + LDS_MISC_OFF)); }
    pg8::ss_t* SS = (pg8::ss_t*)(ws + WS_SS);
    bf16_t* HB0 = (bf16_t*)(ws + WS_HB0); bf16_t* HB1 = (bf16_t*)(ws + WS_HB1);
    bf16_t* PU = (bf16_t*)(ws + WS_PU); bf16_t* HID = (bf16_t*)(ws + WS_HID);
    const int G = gridDim.x, c = blockIdx.x;
    if (IN(0)) { phase_prologue(P, lds); asm volatile("s_waitcnt vmcnt(0) lgkmcnt(0)" ::: "memory"); __syncthreads(); }
    SEAM(0);
    if (IN(1)) {
        { pg8::Gemm g{(const bf16_t*)(ws + WS_XB), (const bf16_t*)(ws + WS_WIN), M_TOK, 8192, 2048}; pg8::StaticOrder S; S.init(M_TOK, 8192, G, c);
          pg8::EpiG1 E{(const float*)(ws + WS_RS0), (const float*)(ws + WS_LB), (bf16_t*)(ws + WS_QIN), (bf16_t*)(ws + WS_KIN), (float*)(ws + WS_DEC), (bf16_t*)(ws + WS_V0), (bf16_t*)(ws + WS_SG)};
          pg8::gemm_phase<pg8::EpiG1, pg8::StaticOrder, true, true>(lds, g, S, E); }
    }
    SEAM(1);
    if (IN(2)) { phase_scan(P, lds); }
    SEAM(2);
    if (IN(3)) {
        phase_weights1(P, lds);
        pg8::Gemm g{(const bf16_t*)P.out, (const bf16_t*)(ws + WS_WAOUT), M_TOK, 2048, 2048}; pg8::StaticOrder S; S.init(M_TOK, 2048, G, c);
        pg8::EpiRes<false> E{(const bf16_t*)(ws + WS_XB), HB0, SS + 0 * M_TOK};
        pg8::gemm_phase<pg8::EpiRes<false>, pg8::StaticOrder, true, true>(lds, g, S, E);
    }
    SEAM(3);
    if (IN(4)) {
        pg8::Gemm g{HB0, (const bf16_t*)(ws + WS_WUP0), M_TOK, 8192, 2048}; pg8::StaticOrder S; S.init(M_TOK, 8192, G, c);
        pg8::EpiUp E{HID, SS + 0 * M_TOK};
        pg8::gemm_phase<pg8::EpiUp, pg8::StaticOrder, true, true>(lds, g, S, E);
    }
    SEAM(4);
    if (IN(5)) {
        pg8::Gemm g{HID, (const bf16_t*)(ws + WS_WDN0), M_TOK, 2048, 8192}; pg8::StaticOrder S; S.init(M_TOK, 2048, G, c);
        pg8::EpiRes<false> E{HB0, HB1, SS + 1 * M_TOK};
        pg8::gemm_phase<pg8::EpiRes<false>, pg8::StaticOrder, true, true>(lds, g, S, E);
    }
    SEAM(5);
    if (IN(6)) {
        pg8::Gemm g{HB1, (const bf16_t*)(ws + WS_WG0), M_TOK, 2048, 2048}; pg8::StaticOrder S; S.init(M_TOK, 2048, G, c);
        pg8::EpiGate<false> E{HB1, nullptr, HB0, SS + 2 * M_TOK, SS + 1 * M_TOK, PU};
        pg8::gemm_phase<pg8::EpiGate<false>, pg8::StaticOrder, true, true>(lds, g, S, E);
    }
    SEAM(6);
    if (IN(7)) {
        pg8::Gemm g{HB0, (const bf16_t*)P.out + (size_t)M_TOK * DMODEL, M_TOK, 6144, 2048}; pg8::StaticOrder S; S.init(M_TOK, 6144, G, c);
        pg8::EpiStore E{(bf16_t*)(ws + WS_KB), (size_t)M_TOK * DMODEL, SS + 2 * M_TOK};
        pg8::gemm_phase<pg8::EpiStore, pg8::StaticOrder, true, true>(lds, g, S, E);
        phase_flogit(P, lds);
    }
    SEAM(7);
    if (IN(8)) { phase_attention(P, lds_raw); }
    SEAM(8);
    if (IN(9)) {
        pg8::Gemm g{(const bf16_t*)(ws + WS_AO), (const bf16_t*)P.out + (size_t)M_TOK * DMODEL + (size_t)6144 * 2048, M_TOK, 2048, 2048}; pg8::StaticOrder S; S.init(M_TOK, 2048, G, c);
        pg8::EpiRes<false> E{HB0, HB1, SS + 3 * M_TOK};
        pg8::gemm_phase<pg8::EpiRes<false>, pg8::StaticOrder, true, true>(lds, g, S, E);
    }
    SEAM(9);
    if (IN(10)) {
        pg8::Gemm g{HB1, (const bf16_t*)(ws + WS_WUP1), M_TOK, 8192, 2048}; pg8::StaticOrder S; S.init(M_TOK, 8192, G, c);
        pg8::EpiUp E{HID, SS + 3 * M_TOK};
        pg8::gemm_phase<pg8::EpiUp, pg8::StaticOrder, true, true>(lds, g, S, E);
    }
    SEAM(10);
    if (IN(11)) {
        pg8::Gemm g{HID, (const bf16_t*)(ws + WS_WDN1), M_TOK, 2048, 8192}; pg8::StaticOrder S; S.init(M_TOK, 2048, G, c);
        pg8::EpiRes<false> E{HB1, HB0, SS + 4 * M_TOK};
        pg8::gemm_phase<pg8::EpiRes<false>, pg8::StaticOrder, true, true>(lds, g, S, E);
    }
    SEAM(11);
    if (IN(12)) {
        pg8::Gemm g{HB0, (const bf16_t*)(ws + WS_WG1), M_TOK, 2048, 2048}; pg8::StaticOrder S; S.init(M_TOK, 2048, G, c);
        pg8::EpiGate<false> E{HB0, nullptr, HB1, SS + 5 * M_TOK, SS + 4 * M_TOK, PU + (size_t)M_TOK * DMODEL};
        pg8::gemm_phase<pg8::EpiGate<false>, pg8::StaticOrder, true, true>(lds, g, S, E);
    }
    SEAM(12);
    if (IN(13)) { phase_final(P); }
#undef IN
#undef SEAM
}

#ifndef MK_SINGLE
#define MK_SINGLE 1
#endif
extern "C" void kernel_launch(void* const* d_in, const int* in_sizes, int n_in, void* d_out, int out_size, void* d_ws, size_t ws_size, hipStream_t stream) {
    static int grid = 0;
    if (grid == 0) {
        if (n_in != 19 || out_size != M_TOK * DMODEL || ws_size < WS_END) { fprintf(stderr, "kernel_launch: unexpected shapes (n_in %d out %d ws %zu need %zu)\n", n_in, out_size, ws_size, (size_t)WS_END); grid = -1; return; }
        int dev = 0, cus = 0, per_cu = 0;
        (void)hipGetDevice(&dev); (void)hipDeviceGetAttribute(&cus, hipDeviceAttributeMultiprocessorCount, dev);
        if (hipFuncSetAttribute((const void*)fwd, hipFuncAttributeMaxDynamicSharedMemorySize, LDS_BYTES) != hipSuccess) { fprintf(stderr, "kernel_launch: hipFuncSetAttribute failed\n"); grid = -1; return; }
        if (hipOccupancyMaxActiveBlocksPerMultiprocessor(&per_cu, (const void*)fwd, NTHREADS, LDS_BYTES) != hipSuccess || per_cu < 1) { fprintf(stderr, "kernel_launch: occupancy query failed (%d)\n", per_cu); per_cu = 1; }
        (void)hipGetLastError();
        grid = cus * per_cu; if (grid <= 0) grid = 256;
    }
    if (grid < 0) return;
    Params p{};
    for (int i = 0; i < 19; ++i) p.in[i] = (const float*)d_in[i];
    p.out = (float*)d_out; p.ws = (unsigned char*)d_ws;
#if MK_SINGLE
    p.ph_lo = 0; p.ph_hi = NPHASES; p.coop = 1;
    void* args[] = {&p};
    hipError_t e = hipLaunchCooperativeKernel((const void*)fwd, dim3(grid), dim3(NTHREADS), args, LDS_BYTES, stream);
    if (e != hipSuccess) fprintf(stderr, "cooperative launch failed: %s (grid %d)\n", hipGetErrorString(e), grid);
#else
    for (int ph = 0; ph < NPHASES; ++ph) { p.ph_lo = ph; p.ph_hi = ph + 1; p.coop = 0;
        hipLaunchKernelGGL(fwd, dim3(grid), dim3(NTHREADS), LDS_BYTES, stream, p); }
#endif
}
```
